# Optimizing an MI355X kernel written in HIP

```python
import jax, jax.numpy as jnp
from jax import lax
import numpy as np

D_MODEL = 2048
BATCH = 8
SEQ = 4096
DEPTH = 1
DEC_BATCH = 16
DEC_SEQ = 64
PAST_LEN = 2048

CHUNK = 64
D_A = D_MODEL // 2
DK_A = 128
H_A = D_A // DK_A
DV_A = D_A // H_A
D_B = D_MODEL // 2
H_B = 16
DH_B = D_B // H_B
BAND_CHUNKS = 8
BAND_ROWS = BAND_CHUNKS * CHUNK
REL_CLIP = 128
N_REL = 2 * REL_CLIP + 1
EPS = 1e-6
NEG_INF = -1e30
SPLITS = [int(s) for s in np.cumsum([D_A, D_A, D_A, D_A, D_B, D_B, D_B, D_B, D_MODEL])]
D_IN = 4 * D_A + 4 * D_B + 2 * D_MODEL

kernel_name = "hgrn2_chunkband_parallel_streaming_step"


def rms_norm(x, g):
    xf = x.astype(jnp.float32)
    y = xf * lax.rsqrt(jnp.mean(xf * xf, axis=-1, keepdims=True) + EPS)
    return (y * g.astype(jnp.float32)).astype(x.dtype)


def hgrn2_inputs(zq, zf, zi, lb):
    B, T, _ = zq.shape
    q = jax.nn.silu(zq.astype(jnp.float32)).reshape(B, T, H_A, DK_A)
    zf = zf.astype(jnp.float32).reshape(B, T, H_A, DK_A)
    lb = lb.reshape(H_A, DK_A)
    logf = jnp.log(lb + (1.0 - lb) * jax.nn.sigmoid(zf))
    k = (1.0 - lb) * jax.nn.sigmoid(-zf)
    v = zi.astype(jnp.float32).reshape(B, T, H_A, DV_A)
    return q, k, v, logf


def hgrn2_chunked(q, k, v, logf, s0, chunk_len):
    B, T, H, DK = q.shape
    DV = v.shape[-1]
    n = T // chunk_len
    tri = jnp.tril(jnp.ones((chunk_len, chunk_len), dtype=bool))[None, :, :, None, None]

    def to_chunks(a):
        return a.reshape(B, n, chunk_len, H, a.shape[-1]).swapaxes(0, 1)

    def step(S, inp):
        qc, kc, vc, gc = inp
        b = jnp.cumsum(gc, axis=1)
        o_inter = jnp.einsum('blhk,bhkv->blhv', qc * jnp.exp(b), S)
        diff = b[:, :, None] - b[:, None]
        decay = jnp.where(tri, jnp.exp(jnp.where(tri, diff, 0.0)), 0.0)
        scores = jnp.einsum('bthk,bshk,btshk->bhts', qc, kc, decay)
        o_intra = jnp.einsum('bhts,bshv->bthv', scores, vc)
        b_last = b[:, -1]
        S_new = jnp.exp(b_last)[..., None] * S + jnp.einsum(
            'bshk,bshv->bhkv', kc * jnp.exp(b_last[:, None] - b), vc)
        return S_new, o_inter + o_intra

    S_fin, o = lax.scan(step, s0.astype(jnp.float32),
                        (to_chunks(q), to_chunks(k), to_chunks(v), to_chunks(logf)))
    o = o.swapaxes(0, 1).reshape(B, T, H, DV)
    return o, S_fin


def band_attention(q, k, v, q_pos, k_pos, rel_bias):
    s = jnp.einsum('bqhd,bkhd->bhqk', q.astype(jnp.float32), k.astype(jnp.float32)) * (DH_B ** -0.5)
    rel = jnp.clip(q_pos[:, None] - k_pos[None, :], -REL_CLIP, REL_CLIP) + REL_CLIP
    s = s + rel_bias.astype(jnp.float32)[:, rel][None]
    qc = q_pos // CHUNK
    kc = k_pos // CHUNK
    allowed = (k_pos[None, :] >= 0) & (kc[None, :] <= qc[:, None]) & (kc[None, :] >= qc[:, None] - BAND_CHUNKS)
    s = jnp.where(allowed[None, None], s, NEG_INF)
    p = jax.nn.softmax(s, axis=-1)
    return jnp.einsum('bhqk,bkhd->bqhd', p, v.astype(jnp.float32))


def prompt_band_attention(q, k, v, rel_bias):
    B, T, H, DH = q.shape
    n = T // CHUNK
    pad = jnp.zeros((B, BAND_ROWS, H, DH), k.dtype)
    k_pad = jnp.concatenate([pad, k], axis=1)
    v_pad = jnp.concatenate([pad, v], axis=1)
    band = BAND_ROWS + CHUNK

    def one_chunk(c):
        start = c * CHUNK
        qc = lax.dynamic_slice_in_dim(q, start, CHUNK, axis=1)
        kc = lax.dynamic_slice_in_dim(k_pad, start, band, axis=1)
        vc = lax.dynamic_slice_in_dim(v_pad, start, band, axis=1)
        q_pos = start + jnp.arange(CHUNK, dtype=jnp.int32)
        k_pos = start - BAND_ROWS + jnp.arange(band, dtype=jnp.int32)
        return band_attention(qc, kc, vc, q_pos, k_pos, rel_bias)

    o = lax.map(one_chunk, jnp.arange(n, dtype=jnp.int32))
    return o.swapaxes(0, 1).reshape(B, T, H, DH)


def in_proj(x, norm_pre, w_in):
    z = rms_norm(x, norm_pre) @ w_in
    return jnp.split(z, SPLITS, axis=-1)


def merge_out(x, o_a, o_b, ga, gb, ma, mb, gnorm_a, w_proj_a, w_proj_b, w_out, norm_post):
    B, T, _ = x.shape
    o_a = o_a * lax.rsqrt(jnp.mean(o_a * o_a, axis=-1, keepdims=True) + EPS)
    o_a = o_a.reshape(B, T, D_A) * gnorm_a.astype(jnp.float32)
    o_a = (o_a * jax.nn.silu(ga.astype(jnp.float32))).astype(x.dtype)
    o_b = (o_b.reshape(B, T, D_B) * jax.nn.silu(gb.astype(jnp.float32))).astype(x.dtype)
    p_a = o_a @ w_proj_a
    p_b = o_b @ w_proj_b
    merged = (jax.nn.sigmoid(ma.astype(jnp.float32)) * p_a.astype(jnp.float32)
              + jax.nn.sigmoid(mb.astype(jnp.float32)) * p_b.astype(jnp.float32)).astype(x.dtype)
    return x + rms_norm(merged @ w_out, norm_post)


def layer_prompt(x, lb, norm_pre, w_in, gnorm_a, rel_bias, w_proj_a, w_proj_b, w_out, norm_post):
    B, T, _ = x.shape
    qa, fa, ia, ga, qb, kb, vb, gb, ma, mb = in_proj(x, norm_pre, w_in)
    q, k, v, logf = hgrn2_inputs(qa, fa, ia, lb)
    s0 = jnp.zeros((B, H_A, DK_A, DV_A), jnp.float32)
    o_a, s_fin = hgrn2_chunked(q, k, v, logf, s0, CHUNK)
    qh = qb.reshape(B, T, H_B, DH_B)
    kh = kb.reshape(B, T, H_B, DH_B)
    vh = vb.reshape(B, T, H_B, DH_B)
    o_b = prompt_band_attention(qh, kh, vh, rel_bias)
    y = merge_out(x, o_a, o_b, ga, gb, ma, mb, gnorm_a, w_proj_a, w_proj_b, w_out, norm_post)
    rows = min(BAND_ROWS, T)
    return y, s_fin, kh[:, T - rows:], vh[:, T - rows:]


def layer_sample(x, s0, past_k, past_v, lb, norm_pre, w_in, gnorm_a, rel_bias, w_proj_a, w_proj_b, w_out, norm_post):
    B, T, _ = x.shape
    qa, fa, ia, ga, qb, kb, vb, gb, ma, mb = in_proj(x, norm_pre, w_in)
    q, k, v, logf = hgrn2_inputs(qa, fa, ia, lb)
    o_a, s_fin = hgrn2_chunked(q, k, v, logf, s0, T)
    qh = qb.reshape(B, T, H_B, DH_B)
    kh = kb.reshape(B, T, H_B, DH_B)
    vh = vb.reshape(B, T, H_B, DH_B)
    rows = past_k.shape[1]
    k_all = jnp.concatenate([past_k.astype(kh.dtype), kh], axis=1)
    v_all = jnp.concatenate([past_v.astype(vh.dtype), vh], axis=1)
    q_pos = PAST_LEN + jnp.arange(T, dtype=jnp.int32)
    k_pos = jnp.concatenate([PAST_LEN - rows + jnp.arange(rows, dtype=jnp.int32), q_pos])
    o_b = band_attention(qh, k_all, v_all, q_pos, k_pos, rel_bias)
    y = merge_out(x, o_a, o_b, ga, gb, ma, mb, gnorm_a, w_proj_a, w_proj_b, w_out, norm_post)
    return y, s_fin, kh, vh


def setup_inputs(seed: int = 0) -> dict:
    key = jax.random.key(seed)
    ks = jax.random.split(key, 14)
    kv_rows = min(BAND_ROWS, PAST_LEN)
    f32 = jnp.float32
    return {
        "x_prompt": jax.random.normal(ks[0], (BATCH, SEQ, D_MODEL), f32),
        "x_sample": jax.random.normal(ks[1], (DEC_BATCH, DEC_SEQ, D_MODEL), f32),
        "state_hgrn": 0.3 * jax.random.normal(ks[2], (DEPTH, DEC_BATCH, H_A, DK_A, DV_A), f32),
        "cache_k": jax.random.normal(ks[3], (DEPTH, DEC_BATCH, kv_rows, H_B, DH_B), f32),
        "cache_v": jax.random.normal(ks[4], (DEPTH, DEC_BATCH, kv_rows, H_B, DH_B), f32),
        "norm_pre": 1.0 + 0.05 * jax.random.normal(ks[5], (DEPTH, D_MODEL), f32),
        "w_in": jax.random.normal(ks[6], (DEPTH, D_MODEL, D_IN), f32) * D_MODEL ** -0.5,
        "lb_logits": 0.5 * jax.random.normal(ks[7], (DEPTH + 1, D_A), f32),
        "gnorm_a": 1.0 + 0.05 * jax.random.normal(ks[8], (DEPTH, D_A), f32),
        "rel_bias": 0.1 * jax.random.normal(ks[9], (DEPTH, H_B, N_REL), f32),
        "w_proj_a": jax.random.normal(ks[10], (DEPTH, D_A, D_MODEL), f32) * D_A ** -0.5,
        "w_proj_b": jax.random.normal(ks[11], (DEPTH, D_B, D_MODEL), f32) * D_B ** -0.5,
        "w_out": jax.random.normal(ks[12], (DEPTH, D_MODEL, D_MODEL), f32) * D_MODEL ** -0.5,
        "norm_post": 1.0 + 0.05 * jax.random.normal(ks[13], (DEPTH, D_MODEL), f32),
    }


def reference(x_prompt, x_sample, state_hgrn, cache_k, cache_v, norm_pre, w_in, lb_logits,
              gnorm_a, rel_bias, w_proj_a, w_proj_b, w_out, norm_post):
    lb_all = jnp.cumsum(jax.nn.softmax(lb_logits.astype(jnp.float32), axis=0), axis=0)
    xp, xs = x_prompt, x_sample
    sp_list, kp_list, vp_list, ss_list, ks_list, vs_list = [], [], [], [], [], []
    for l in range(DEPTH):
        xp, sp, kp, vp = layer_prompt(xp, lb_all[l], norm_pre[l], w_in[l], gnorm_a[l], rel_bias[l],
                                      w_proj_a[l], w_proj_b[l], w_out[l], norm_post[l])
        xs, ss, ksn, vsn = layer_sample(xs, state_hgrn[l], cache_k[l], cache_v[l], lb_all[l], norm_pre[l],
                                        w_in[l], gnorm_a[l], rel_bias[l], w_proj_a[l], w_proj_b[l],
                                        w_out[l], norm_post[l])
        sp_list.append(sp); kp_list.append(kp); vp_list.append(vp)
        ss_list.append(ss); ks_list.append(ksn); vs_list.append(vsn)
    new_state_prompt = jnp.stack(sp_list)
    new_k_prompt = jnp.stack(kp_list)
    new_v_prompt = jnp.stack(vp_list)
    new_state_sample = jnp.stack(ss_list)
    new_k_sample = jnp.stack(ks_list)
    new_v_sample = jnp.stack(vs_list)
    return (xp, xs, new_state_prompt, new_k_prompt, new_v_prompt, new_state_sample, new_k_sample, new_v_sample)
```

```cpp
#include <hip/hip_runtime.h>
#include <cstdio>
#include <cstdint>

#ifndef REPEAT_PHASE
#define REPEAT_PHASE -1
#endif
#ifndef PH_MASK
#define PH_MASK 0x1ff
#endif
#ifndef MK_N_LAUNCHES
#define MK_N_LAUNCHES 1
#endif

constexpr int DM = 2048, NBATCH = 8, SEQ = 4096, DBATCH = 16, DSEQ = 64;
constexpr int MP = NBATCH * SEQ, MS = DBATCH * DSEQ, M = MP + MS;
constexpr int DIN = 12288, DA = 1024, DB_ = 1024;
constexpr int HA = 8, DK = 128, HB = 16, DH = 64;
constexpr int NCH = M / 64;
constexpr int NUNIT = NCH * HA;
constexpr int KVROWS = 512, TS = KVROWS + DSEQ;
constexpr float EPS = 1e-6f;
constexpr float LOG2E = 1.4426950408889634f;
constexpr float QSCALE = 0.125f * LOG2E;
constexpr size_t O_YP = 0, O_YS = 67108864, O_SP = 69206016, O_KP = 70254592, O_VP = 74448896, O_SS = 78643200, O_KS = 80740352, O_VS = 81788928, O_END = 82837504;

constexpr size_t MiB = 1u << 20;
constexpr size_t WS_CTL = 0, CTL_ZERO_BYTES = 1 * MiB;
constexpr size_t WS_W2T = 49 * MiB, WS_W3T = 57 * MiB, WS_SQ = 65 * MiB, WS_DD = 70 * MiB;
constexpr size_t WS_OAB = 73 * MiB;
constexpr size_t WS_LF = 205 * MiB;
constexpr size_t WS_VA = 271 * MiB;
constexpr size_t WS_GA = 337 * MiB;
constexpr size_t WS_GB = 403 * MiB;
constexpr size_t WS_KB = 469 * MiB;
constexpr size_t WS_VB = 551 * MiB;
constexpr size_t WS_SA = 633 * MiB;
constexpr size_t WS_SB = 765 * MiB;
constexpr size_t WS_W1T = 1 * MiB;
constexpr size_t WS_ST = 469 * MiB;
constexpr size_t WS_MG = 205 * MiB;
constexpr size_t WS_UO = 469 * MiB;
constexpr size_t WS_END = 897 * MiB;
constexpr size_t KB_S = (size_t)NBATCH * HB * SEQ * DH;

constexpr int CW_TMO = 0, CW_CODE = 1, CW_BAR = 4096;

constexpr int LDS_BYTES = 163840;
constexpr int MISC_OFF = LDS_BYTES - 256;
constexpr int NWAVES = 8;

#define GAS __attribute__((address_space(1)))
#define LAS __attribute__((address_space(3)))
typedef unsigned short bf16;
typedef unsigned v4u __attribute__((ext_vector_type(4)));
typedef unsigned v2u __attribute__((ext_vector_type(2)));
typedef float f32x4 __attribute__((ext_vector_type(4)));
typedef float f32x16 __attribute__((ext_vector_type(16)));
typedef short bf16x8 __attribute__((ext_vector_type(8)));
typedef GAS unsigned gu32;
#define RLX_AGENT __ATOMIC_RELAXED, __HIP_MEMORY_SCOPE_AGENT
#define LDS_WAIT() asm volatile("s_waitcnt lgkmcnt(0)" ::: "memory")
#define VM_WAIT() asm volatile("s_waitcnt vmcnt(0)" ::: "memory")
__device__ __forceinline__ unsigned f2bf(float f) { unsigned u = __builtin_bit_cast(unsigned, f); return (u + 0x7fffu + ((u >> 16) & 1u)) >> 16; }
typedef float f32x2_g __attribute__((ext_vector_type(2))); typedef __bf16 bf16x2_g __attribute__((ext_vector_type(2)));
__device__ __forceinline__ unsigned pk2(float lo, float hi) { const f32x2_g v = {lo, hi}; const bf16x2_g b = __builtin_convertvector(v, bf16x2_g); return __builtin_bit_cast(unsigned, b); }
__device__ __forceinline__ float bflo(unsigned w) { return __builtin_bit_cast(float, w << 16); }
__device__ __forceinline__ float bfhi(unsigned w) { return __builtin_bit_cast(float, w & 0xffff0000u); }
__device__ __forceinline__ float bf2f(bf16 h) { return __builtin_bit_cast(float, (unsigned)h << 16); }
__device__ __forceinline__ unsigned pkh2(float lo, float hi) { const _Float16 a = (_Float16)lo, b = (_Float16)hi; return (unsigned)__builtin_bit_cast(unsigned short, a) | ((unsigned)__builtin_bit_cast(unsigned short, b) << 16); }
__device__ __forceinline__ float h2f(unsigned short h) { return (float)__builtin_bit_cast(_Float16, h); }
__device__ __forceinline__ float fast_sigmoid(float z) { return __builtin_amdgcn_rcpf(1.0f + __expf(-z)); }
__device__ __forceinline__ float fast_silu(float z) { return z * fast_sigmoid(z); }

struct Args { const float* in[14]; float* out; unsigned char* ws; int ph_lo, ph_hi, li, pad; };
typedef const __attribute__((address_space(4))) Args* KArgs;
__device__ __forceinline__ KArgs kargs() { KArgs p = (KArgs)__builtin_amdgcn_kernarg_segment_ptr(); asm volatile("" : "+s"(p)); return p; }
#define KIN(i) (kargs()->in[i])

namespace pg8 {
#define PG8_LAS __attribute__((address_space(3)))
typedef unsigned short bf16_t;
typedef short bf16x8 __attribute__((ext_vector_type(8)));
typedef float f32x4 __attribute__((ext_vector_type(4)));
typedef unsigned u32x4 __attribute__((ext_vector_type(4)));
constexpr int BM = 256, BK = 64, HALF = 128, HTB = HALF * BK * 2  , STAGE_BYTES = 8 * HTB, NXCD = 8, WGM = 8;

__host__ __device__ __forceinline__ int lds_byte(int r, int c) { const int st = (r >> 4) * 2 + (c >> 5), rr = r & 15, cc = c & 31, ob = rr * 64 + cc * 2; return st * 1024 + (ob ^ (((ob >> 9) & 1) << 5)); }
__host__ __device__ __forceinline__ void stage_rc(int b, int& R, int& C) { const int st = b / 1024, sb = b % 1024, swz = sb ^ (((sb >> 9) & 1) << 5); R = (st >> 1) * 16 + swz / 64; C = (st & 1) * 32 + (swz % 64) / 2; }
__host__ __device__ __forceinline__ int perm32(int rho) { const int n = rho >> 4, i = rho & 15; return 8 * (i >> 2) + 4 * n + (i & 3); }

struct Unit { int pm, pn, tr; };
struct Gemm { const bf16_t* A; const bf16_t* Bt; int M, N, K; };

struct StaticOrder {
    int nM, nN, nwg, G, c;
    __host__ __device__ void init(int M, int N, int G_, int c_) { nM = M / BM; nN = N / BM; nwg = nM * nN; G = G_; c = c_; }
    __host__ __device__ bool next(int i, Unit& u) const {
        const long L = (long)i * G + c; if (L >= nwg) return false;
        int wgid = (int)L; { const int q = nwg / NXCD, r = nwg % NXCD, xcd = wgid % NXCD, off = wgid / NXCD; wgid = (xcd < r ? xcd * (q + 1) : r * (q + 1) + (xcd - r) * q) + off; }
        const int nig = WGM * nN, gid = wgid / nig, fm = gid * WGM, gsz = (nM - fm) < WGM ? (nM - fm) : WGM;
        u.pm = fm + ((wgid % nig) % gsz); u.pn = (wgid % nig) / gsz; u.tr = 0; return true;
    }
    __device__ __forceinline__ void a_ready(const Unit&) const {}
    __device__ __forceinline__ void done(const Unit&) const {}
};
struct Order1 : StaticOrder {
    __host__ __device__ bool next(int i, Unit& u) const { if (!StaticOrder::next(i, u)) return false; const int ty = u.pn >> 2; u.tr = (ty == 2 || ty == 6) ? 1 : 0; return true; }
};

typedef float f32x2_t __attribute__((ext_vector_type(2))); typedef __bf16 bf16x2_t __attribute__((ext_vector_type(2)));
__device__ __forceinline__ unsigned cvt_pk_bf16(float lo, float hi) { const f32x2_t v = {lo, hi}; const bf16x2_t b = __builtin_convertvector(v, bf16x2_t); return __builtin_bit_cast(unsigned, b); }
#define EPI_FOR_ALL _Pragma("unroll") for (int ai = 0; ai < 2; ++ai) _Pragma("unroll") for (int m = 0; m < 4; ++m) _Pragma("unroll") for (int bj = 0; bj < 2; ++bj)
struct Epi1 {
    static constexpr bool PERM = true, AFTER_DRAIN = false, MIDHOOK = false;
    int dummy;
    __device__ __forceinline__ void operator()(const f32x4 (&acc)[2][2][4][2], const Unit& u, int wr, int wc, int fr, int fq) const {
        { int l_; asm volatile("v_mbcnt_lo_u32_b32 %0, -1, 0\n\tv_mbcnt_hi_u32_b32 %0, -1, %0" : "=v"(l_)); fr = l_ & 15; fq = l_ >> 4; } asm volatile("" : "+s"(wr), "+s"(wc));
        KArgs ka_ = kargs(); unsigned char* const ws = ka_->ws; float* const out = ka_->out; const float* const lbl = ka_->in[7];
        bf16_t* const OAB = (bf16_t*)(ws + WS_OAB); bf16_t* const LF = (bf16_t*)(ws + WS_LF); bf16_t* const VA = (bf16_t*)(ws + WS_VA); bf16_t* const GA = (bf16_t*)(ws + WS_GA); bf16_t* const GB = (bf16_t*)(ws + WS_GB);
        bf16_t* const KB = (bf16_t*)(ws + WS_KB); bf16_t* const VB = (bf16_t*)(ws + WS_VB); bf16_t* const SA = (bf16_t*)(ws + WS_SA); bf16_t* const SB = (bf16_t*)(ws + WS_SB);
        int ty = u.pn < 32 ? (u.pn >> 2) : (u.pn < 40 ? 8 : 9);
#ifdef TY_ONLY
        ty = TY_ONLY;
#endif
        const int rbase = (u.tr ? u.pn : u.pm) * BM + wr * 64 + fr;
        const int cbase = (u.tr ? u.pm : u.pn) * BM + wc * 32 + 8 * fq;
        if (dummy) {
            bf16_t* const DUM = (bf16_t*)(ws + 897 * MiB);
            EPI_FOR_ALL { const int r = rbase + ai * 128 + m * 16, c = cbase + bj * 128; const f32x4 v0 = acc[ai][bj][m][0], v1 = acc[ai][bj][m][1];
                u32x4 w; w.x = cvt_pk_bf16(v0[0], v0[1]); w.y = cvt_pk_bf16(v0[2], v0[3]); w.z = cvt_pk_bf16(v1[0], v1[1]); w.w = cvt_pk_bf16(v1[2], v1[3]);
                *(u32x4*)(DUM + (unsigned)((r & 16383) * 2048 + (c & 2047))) = w; }
        } else if (ty == 0) {
            EPI_FOR_ALL { const int r = rbase + ai * 128 + m * 16, c = cbase + bj * 128; const f32x4 v0 = acc[ai][bj][m][0], v1 = acc[ai][bj][m][1];
                u32x4 w; w.x = cvt_pk_bf16(fast_silu(v0[0]), fast_silu(v0[1])); w.y = cvt_pk_bf16(fast_silu(v0[2]), fast_silu(v0[3])); w.z = cvt_pk_bf16(fast_silu(v1[0]), fast_silu(v1[1])); w.w = cvt_pk_bf16(fast_silu(v1[2]), fast_silu(v1[3]));
                *(u32x4*)(OAB + (unsigned)(r * 2048 + c)) = w; }
        } else if (ty == 1) {
            float oml[2][8];
#pragma unroll
            for (int bj = 0; bj < 2; ++bj) { const int cc = cbase + bj * 128 - 1024;
#pragma unroll
                for (int e = 0; e < 8; ++e) { const float l0 = lbl[cc + e], l1 = lbl[1024 + cc + e]; const float lb = __builtin_amdgcn_rcpf(1.0f + __expf(l1 - l0)); oml[bj][e] = 1.0f - lb; } }
            EPI_FOR_ALL { const int r = rbase + ai * 128 + m * 16, cc = cbase + bj * 128 - 1024; const f32x4 v0 = acc[ai][bj][m][0], v1 = acc[ai][bj][m][1];
                float lf[8];
#pragma unroll
                for (int e = 0; e < 8; ++e) { const float z = e < 4 ? v0[e & 3] : v1[e & 3]; const float kq = oml[bj][e] * __builtin_amdgcn_rcpf(1.0f + __expf(z)); const float ser = -kq * (1.0f + kq * (0.5f + kq * (0.33333334f + kq * (0.25f + kq * 0.2f)))); lf[e] = kq < 0.0625f ? ser : __logf(1.0f - kq); }
                u32x4 w; w.x = pkh2(lf[0], lf[1]); w.y = pkh2(lf[2], lf[3]); w.z = pkh2(lf[4], lf[5]); w.w = pkh2(lf[6], lf[7]);
                const int gc = r >> 6, t = r & 63, h = cc >> 7, kk = cc & 127;
                *(u32x4*)(LF + (unsigned)(((gc * 8 + h) * 64 + t) * 128 + kk)) = w; }
        } else if (ty == 2) {
            EPI_FOR_ALL { const int cc = rbase + ai * 128 + m * 16 - 2048, tg = cbase + bj * 128; const f32x4 v0 = acc[ai][bj][m][0], v1 = acc[ai][bj][m][1];
                u32x4 w; w.x = cvt_pk_bf16(v0[0], v0[1]); w.y = cvt_pk_bf16(v0[2], v0[3]); w.z = cvt_pk_bf16(v1[0], v1[1]); w.w = cvt_pk_bf16(v1[2], v1[3]);
                const int gc = tg >> 6, t0 = tg & 63, h = cc >> 7, dv = cc & 127;
                *(u32x4*)(VA + (unsigned)(((gc * 8 + h) * 128 + dv) * 64 + t0)) = w; }
        } else if (ty == 3) {
            EPI_FOR_ALL { const int r = rbase + ai * 128 + m * 16, cc = cbase + bj * 128 - 3072; const f32x4 v0 = acc[ai][bj][m][0], v1 = acc[ai][bj][m][1];
                u32x4 w; w.x = cvt_pk_bf16(fast_silu(v0[0]), fast_silu(v0[1])); w.y = cvt_pk_bf16(fast_silu(v0[2]), fast_silu(v0[3])); w.z = cvt_pk_bf16(fast_silu(v1[0]), fast_silu(v1[1])); w.w = cvt_pk_bf16(fast_silu(v1[2]), fast_silu(v1[3]));
                const int gc = r >> 6, t = r & 63, h = cc >> 7, kk = cc & 127;
                *(u32x4*)(GA + (unsigned)(((gc * 8 + h) * 64 + t) * 128 + kk)) = w; }
        } else if (ty == 4) {
            EPI_FOR_ALL { const int r = rbase + ai * 128 + m * 16, cc = cbase + bj * 128 - 4096; const f32x4 v0 = acc[ai][bj][m][0] * QSCALE, v1 = acc[ai][bj][m][1] * QSCALE;
                u32x4 w; w.x = cvt_pk_bf16(v0[0], v0[1]); w.y = cvt_pk_bf16(v0[2], v0[3]); w.z = cvt_pk_bf16(v1[0], v1[1]); w.w = cvt_pk_bf16(v1[2], v1[3]);
                *(u32x4*)(OAB + (unsigned)(r * 2048 + 1024 + cc)) = w; }
        } else if (ty == 5) {
            EPI_FOR_ALL { const int r = rbase + ai * 128 + m * 16, cc = cbase + bj * 128 - 5120; const f32x4 v0 = acc[ai][bj][m][0], v1 = acc[ai][bj][m][1];
                u32x4 w; w.x = cvt_pk_bf16(v0[0], v0[1]); w.y = cvt_pk_bf16(v0[2], v0[3]); w.z = cvt_pk_bf16(v1[0], v1[1]); w.w = cvt_pk_bf16(v1[2], v1[3]);
                const int h = cc >> 6, d = cc & 63;
                if (r < MP) { const int b = r >> 12, t = r & 4095;
                    *(u32x4*)(KB + (unsigned)(((b * 16 + h) * SEQ + t) * 64 + d)) = w;
                    if (t >= SEQ - KVROWS) { float* o = out + O_KP + (unsigned)((b * KVROWS + t - (SEQ - KVROWS)) * 1024 + cc); *(f32x4*)o = v0; *(f32x4*)(o + 4) = v1; }
                } else { const int rs = r - MP, sb = rs >> 6, t = rs & 63;
                    *(u32x4*)(KB + (unsigned)((int)KB_S + ((sb * 16 + h) * TS + KVROWS + t) * 64 + d)) = w;
                    float* o = out + (unsigned)((int)O_KS + rs * 1024 + cc); *(f32x4*)o = v0; *(f32x4*)(o + 4) = v1; } }
        } else if (ty == 6) {
            EPI_FOR_ALL { const int cc = rbase + ai * 128 + m * 16 - 6144, tg = cbase + bj * 128; const f32x4 v0 = acc[ai][bj][m][0], v1 = acc[ai][bj][m][1];
                u32x4 w; w.x = cvt_pk_bf16(v0[0], v0[1]); w.y = cvt_pk_bf16(v0[2], v0[3]); w.z = cvt_pk_bf16(v1[0], v1[1]); w.w = cvt_pk_bf16(v1[2], v1[3]);
                const int h = cc >> 6, d = cc & 63;
                if (tg < MP) { const int b = tg >> 12, t0 = tg & 4095;
                    *(u32x4*)(VB + (unsigned)(((b * 16 + h) * 64 + d) * SEQ + t0)) = w;
                    if (t0 >= SEQ - KVROWS) { float* o = out + O_VP + (unsigned)((b * KVROWS + t0 - (SEQ - KVROWS)) * 1024 + cc);
#pragma unroll
                        for (int e = 0; e < 8; ++e) o[e * 1024] = e < 4 ? v0[e & 3] : v1[e & 3]; }
                } else { const int rs = tg - MP, sb = rs >> 6, t0 = rs & 63;
                    *(u32x4*)(VB + (unsigned)((int)KB_S + ((sb * 16 + h) * 64 + d) * TS + KVROWS + t0)) = w;
                    float* o = out + (unsigned)((int)O_VS + rs * 1024 + cc);
#pragma unroll
                    for (int e = 0; e < 8; ++e) o[e * 1024] = e < 4 ? v0[e & 3] : v1[e & 3]; } }
        } else if (ty == 7) {
            EPI_FOR_ALL { const int r = rbase + ai * 128 + m * 16, cc = cbase + bj * 128 - 7168; const f32x4 v0 = acc[ai][bj][m][0], v1 = acc[ai][bj][m][1];
                u32x4 w; w.x = cvt_pk_bf16(fast_silu(v0[0]), fast_silu(v0[1])); w.y = cvt_pk_bf16(fast_silu(v0[2]), fast_silu(v0[3])); w.z = cvt_pk_bf16(fast_silu(v1[0]), fast_silu(v1[1])); w.w = cvt_pk_bf16(fast_silu(v1[2]), fast_silu(v1[3]));
                *(u32x4*)(GB + (unsigned)(r * 1024 + cc)) = w; }
        } else {
            bf16_t* dst = ty == 8 ? SA : SB; const int coff = ty == 8 ? 8192 : 10240;
            EPI_FOR_ALL { const int r = rbase + ai * 128 + m * 16, cc = cbase + bj * 128 - coff; const f32x4 v0 = acc[ai][bj][m][0], v1 = acc[ai][bj][m][1];
                u32x4 w; w.x = cvt_pk_bf16(fast_sigmoid(v0[0]), fast_sigmoid(v0[1])); w.y = cvt_pk_bf16(fast_sigmoid(v0[2]), fast_sigmoid(v0[3])); w.z = cvt_pk_bf16(fast_sigmoid(v1[0]), fast_sigmoid(v1[1])); w.w = cvt_pk_bf16(fast_sigmoid(v1[2]), fast_sigmoid(v1[3]));
                *(u32x4*)(dst + (unsigned)(r * 2048 + cc)) = w; }
        }
    }
};
struct Epi2 {
    static constexpr bool PERM = true, AFTER_DRAIN = false, MIDHOOK = true;
    __device__ __forceinline__ void mid(f32x4 (&acc)[2][2][4][2], const Unit& u, int wr, int wc, int fr, int fq) const {
        unsigned char* const ws_ = kargs()->ws; const bf16_t* const SA = (const bf16_t*)(ws_ + WS_SA); const bf16_t* const SB = (const bf16_t*)(ws_ + WS_SB);
        { int l_; asm volatile("v_mbcnt_lo_u32_b32 %0, -1, 0\n\tv_mbcnt_hi_u32_b32 %0, -1, %0" : "=v"(l_)); fr = l_ & 15; fq = l_ >> 4; } asm volatile("" : "+s"(wr), "+s"(wc));
        const int rbase = u.pm * BM + wr * 64 + fr, cbase = u.pn * BM + wc * 32 + 8 * fq;
        EPI_FOR_ALL { const unsigned off = (unsigned)((rbase + ai * 128 + m * 16) * 2048 + cbase + bj * 128);
            const u32x4 a = *(const u32x4*)(SA + off), b = *(const u32x4*)(SB + off);
            f32x4 r0, r1;
            r0[0] = bflo(a.x) * __builtin_amdgcn_rcpf(bflo(b.x)); r0[1] = bfhi(a.x) * __builtin_amdgcn_rcpf(bfhi(b.x)); r0[2] = bflo(a.y) * __builtin_amdgcn_rcpf(bflo(b.y)); r0[3] = bfhi(a.y) * __builtin_amdgcn_rcpf(bfhi(b.y));
            r1[0] = bflo(a.z) * __builtin_amdgcn_rcpf(bflo(b.z)); r1[1] = bfhi(a.z) * __builtin_amdgcn_rcpf(bfhi(b.z)); r1[2] = bflo(a.w) * __builtin_amdgcn_rcpf(bflo(b.w)); r1[3] = bfhi(a.w) * __builtin_amdgcn_rcpf(bfhi(b.w));
            acc[ai][bj][m][0] *= r0; acc[ai][bj][m][1] *= r1; if (bj == 1 && (m & 1)) asm volatile("" ::: "memory"); }
    }
    __device__ __forceinline__ void operator()(const f32x4 (&acc)[2][2][4][2], const Unit& u, int wr, int wc, int fr, int fq) const {
        { int l_; asm volatile("v_mbcnt_lo_u32_b32 %0, -1, 0\n\tv_mbcnt_hi_u32_b32 %0, -1, %0" : "=v"(l_)); fr = l_ & 15; fq = l_ >> 4; } asm volatile("" : "+s"(wr), "+s"(wc));
        unsigned char* const ws_ = kargs()->ws; const bf16_t* const SB = (const bf16_t*)(ws_ + WS_SB); bf16_t* const MG = (bf16_t*)(ws_ + WS_MG);
        const int rbase = u.pm * BM + wr * 64 + fr, cbase = u.pn * BM + wc * 32 + 8 * fq;
        EPI_FOR_ALL { const unsigned off = (unsigned)((rbase + ai * 128 + m * 16) * 2048 + cbase + bj * 128);
            const u32x4 b = *(const u32x4*)(SB + off); const f32x4 v0 = acc[ai][bj][m][0], v1 = acc[ai][bj][m][1];
            u32x4 w; w.x = cvt_pk_bf16(v0[0] * bflo(b.x), v0[1] * bfhi(b.x)); w.y = cvt_pk_bf16(v0[2] * bflo(b.y), v0[3] * bfhi(b.y)); w.z = cvt_pk_bf16(v1[0] * bflo(b.z), v1[1] * bfhi(b.z)); w.w = cvt_pk_bf16(v1[2] * bflo(b.w), v1[3] * bfhi(b.w));
            *(u32x4*)(MG + off) = w; if (bj == 1 && (m & 1)) asm volatile("" ::: "memory"); }
    }
};
struct Epi3 {
    static constexpr bool PERM = true, AFTER_DRAIN = false, MIDHOOK = false;
    __device__ __forceinline__ void operator()(const f32x4 (&acc)[2][2][4][2], const Unit& u, int wr, int wc, int fr, int fq) const {
        { int l_; asm volatile("v_mbcnt_lo_u32_b32 %0, -1, 0\n\tv_mbcnt_hi_u32_b32 %0, -1, %0" : "=v"(l_)); fr = l_ & 15; fq = l_ >> 4; } asm volatile("" : "+s"(wr), "+s"(wc));
        unsigned char* const ws_ = kargs()->ws; bf16_t* const UO = (bf16_t*)(ws_ + WS_UO); float* const SQ = (float*)(ws_ + WS_SQ);
        const int rbase = u.pm * BM + wr * 64 + fr, cbase = u.pn * BM + wc * 32 + 8 * fq;
#pragma unroll
        for (int ai = 0; ai < 2; ++ai)
#pragma unroll
            for (int m = 0; m < 4; ++m) { const int r = rbase + ai * 128 + m * 16; float s = 0.f;
#pragma unroll
                for (int bj = 0; bj < 2; ++bj) { const f32x4 v0 = acc[ai][bj][m][0], v1 = acc[ai][bj][m][1];
                    s += (v0[0] * v0[0] + v0[1] * v0[1]) + (v0[2] * v0[2] + v0[3] * v0[3]) + (v1[0] * v1[0] + v1[1] * v1[1]) + (v1[2] * v1[2] + v1[3] * v1[3]);
                    u32x4 w; w.x = cvt_pk_bf16(v0[0], v0[1]); w.y = cvt_pk_bf16(v0[2], v0[3]); w.z = cvt_pk_bf16(v1[0], v1[1]); w.w = cvt_pk_bf16(v1[2], v1[3]);
                    *(u32x4*)(UO + (unsigned)(r * 2048 + cbase + bj * 128)) = w; }
                s += __shfl_xor(s, 16); s += __shfl_xor(s, 32);
                if (fq == 0) SQ[(unsigned)(r * 32 + u.pn * 4 + wc)] = s; }
    }
};
#undef EPI_FOR_ALL

template <class Epi, class Sched, bool ALIGN_EPI = false, bool SP2 = false>
__device__ __forceinline__ void gemm_phase(PG8_LAS unsigned char* lds, const Gemm g, const Sched& S, const Epi& E, int wave_s) {
    int lane; asm volatile("v_mbcnt_lo_u32_b32 %0, -1, 0\n\tv_mbcnt_hi_u32_b32 %0, -1, %0" : "=v"(lane));
    const int wid = wave_s, tid = wid * 64 + lane, wr = wid >> 2, wc = wid & 3, fr = lane & 15, fq = lane >> 4;
    const int K = g.K, nt = K / BK;
    unsigned voffA[2], voffB[2];
#pragma unroll
    for (int i = 0; i < 2; ++i) { int R, C; stage_rc(tid * 16 + i * 8192, R, C); const int Rb = Epi::PERM ? ((R & ~31) + perm32(R & 31)) : R;
        voffA[i] = (unsigned)(R * K + C) * 2u; voffB[i] = (unsigned)(Rb * K + C) * 2u; }
    const size_t kstep = (size_t)(BK * 2);
    const size_t hstep = (size_t)HALF * K * 2;
    const size_t tstep = 2 * hstep;
    const unsigned ldsw = (unsigned)wid * 1024u;
    const int aoff = lds_byte(wr * 64 + fr, fq * 8), boff = lds_byte(wc * 32 + fr, fq * 8);
#define PG8_SA(b, h) (((b) * 2 + (h)) * HTB)
#define PG8_SB(b, h) ((4 + (b) * 2 + (h)) * HTB)
#define PG8_STAGE(bufoff, gbase, voff) do { _Pragma("unroll") for (int _i = 0; _i < 2; ++_i) \
        __builtin_amdgcn_global_load_lds((const unsigned*)((const char*)(gbase) + (voff)[_i]), (PG8_LAS unsigned*)(lds + (bufoff) + ldsw + _i * 8192), 16, 0, 0); } while (0)
#define PG8_LDA(dst, b, h) do { _Pragma("unroll") for (int m = 0; m < 4; ++m) _Pragma("unroll") for (int k = 0; k < 2; ++k) dst[m][k] = *(const PG8_LAS bf16x8*)(lds + PG8_SA(b, h) + aoff + m * 2048 + k * 1024); } while (0)
#define PG8_LDB(dst, b, h) do { _Pragma("unroll") for (int n = 0; n < 2; ++n) _Pragma("unroll") for (int k = 0; k < 2; ++k) dst[n][k] = *(const PG8_LAS bf16x8*)(lds + PG8_SB(b, h) + boff + n * 2048 + k * 1024); } while (0)
#define PG8_MMA(ai, bj, At, Bt) do { __builtin_amdgcn_s_setprio(1); _Pragma("unroll") for (int m = 0; m < 4; ++m) _Pragma("unroll") for (int n = 0; n < 2; ++n) _Pragma("unroll") for (int k = 0; k < 2; ++k) \
        acc[ai][bj][m][n] = __builtin_amdgcn_mfma_f32_16x16x32_bf16(Bt[n][k], At[m][k], acc[ai][bj][m][n], 0, 0, 0); __builtin_amdgcn_s_setprio(0); } while (0)
#define PG8_WAIT_V(n) asm volatile("s_waitcnt vmcnt(" #n ")" ::: "memory")
#define PG8_WAIT_L(n) asm volatile("s_waitcnt lgkmcnt(" #n ")" ::: "memory")
#define PG8_BAR __builtin_amdgcn_s_barrier()
#define PG8_SCHED __builtin_amdgcn_sched_barrier(0)
    Unit cur, nxt; int ui = 0;
    if (!S.next(0, cur)) return;
    f32x4 acc[2][2][4][2];
#pragma unroll
    for (int a = 0; a < 2; ++a)
#pragma unroll
        for (int b = 0; b < 2; ++b)
#pragma unroll
            for (int m = 0; m < 4; ++m)
#pragma unroll
                for (int n = 0; n < 2; ++n) acc[a][b][m][n] = (f32x4){0.f, 0.f, 0.f, 0.f};
    bf16x8 At[4][2], B0[2][2], B1[2][2];
    const char* cA = cur.tr ? (const char*)g.Bt + (size_t)cur.pn * tstep : (const char*)g.A + (size_t)cur.pm * tstep;
    const char* cB = cur.tr ? (const char*)g.A + (size_t)cur.pm * tstep : (const char*)g.Bt + (size_t)cur.pn * tstep;
    S.a_ready(cur);
    if constexpr (SP2) {
        PG8_STAGE(PG8_SB(0, 0), cB, voffB); PG8_STAGE(PG8_SB(0, 1), cB + hstep, voffB); PG8_STAGE(PG8_SA(0, 0), cA, voffA); PG8_STAGE(PG8_SA(0, 1), cA + hstep, voffA);
        if (wr == 1) PG8_BAR;
        PG8_WAIT_V(2); PG8_BAR;
        PG8_STAGE(PG8_SB(1, 0), cB + kstep, voffB); PG8_STAGE(PG8_SA(1, 0), cA + kstep, voffA); PG8_STAGE(PG8_SB(1, 1), cB + hstep + kstep, voffB);
        PG8_WAIT_V(6); PG8_BAR;
    } else {
        PG8_STAGE(PG8_SB(0, 0), cB, voffB); PG8_STAGE(PG8_SA(0, 0), cA, voffA); PG8_STAGE(PG8_SB(0, 1), cB + hstep, voffB); PG8_STAGE(PG8_SA(0, 1), cA + hstep, voffA);
        if (wr == 1) PG8_BAR;
        PG8_WAIT_V(4); PG8_BAR;
        PG8_STAGE(PG8_SB(1, 0), cB + kstep, voffB); PG8_STAGE(PG8_SA(1, 0), cA + kstep, voffA); PG8_STAGE(PG8_SB(1, 1), cB + hstep + kstep, voffB);
        PG8_WAIT_V(6); PG8_BAR;
    }
    for (;;) {
        const bool has_next = S.next(ui + 1, nxt);
        const char* nA = has_next ? (nxt.tr ? (const char*)g.Bt + (size_t)nxt.pn * tstep : (const char*)g.A + (size_t)nxt.pm * tstep) : cA;
        const char* nB = has_next ? (nxt.tr ? (const char*)g.A + (size_t)nxt.pm * tstep : (const char*)g.Bt + (size_t)nxt.pn * tstep) : cB;
        for (int t = 0; t < nt; t += 2) {
            if constexpr (Epi::MIDHOOK) { if (t == (nt >> 1)) E.mid(acc, cur, wr, wc, fr, fq); }
            const bool last = (t == nt - 2);
            const char* a1 = cA + (size_t)(t + 1) * kstep;
            const char* a2 = last ? nA : cA + (size_t)(t + 2) * kstep; const char* b2 = last ? nB : cB + (size_t)(t + 2) * kstep;
            const char* a3 = a2 + kstep; const char* b3 = b2 + kstep;
            if (last && has_next) S.a_ready(nxt);
            if constexpr (SP2) {
            PG8_LDB(B0, 0, 0); PG8_LDB(B1, 0, 1); PG8_SCHED; PG8_LDA(At, 0, 0); PG8_STAGE(PG8_SA(1, 1), a1 + hstep, voffA);
            PG8_WAIT_V(8); PG8_WAIT_L(0); PG8_BAR; PG8_MMA(0, 0, At, B0); PG8_MMA(0, 1, At, B1); PG8_BAR; PG8_SCHED;
            PG8_LDA(At, 0, 1); PG8_STAGE(PG8_SB(0, 0), b2, voffB); PG8_STAGE(PG8_SB(0, 1), b2 + hstep, voffB); PG8_STAGE(PG8_SA(0, 0), a2, voffA);
            PG8_WAIT_V(8); PG8_WAIT_L(0); PG8_BAR; PG8_MMA(1, 0, At, B0); PG8_MMA(1, 1, At, B1); PG8_BAR; PG8_SCHED;
            PG8_LDB(B0, 1, 0); PG8_LDB(B1, 1, 1); PG8_SCHED; PG8_LDA(At, 1, 0); PG8_STAGE(PG8_SA(0, 1), a2 + hstep, voffA);
            PG8_WAIT_V(8); PG8_WAIT_L(0); PG8_BAR; PG8_MMA(0, 0, At, B0); PG8_MMA(0, 1, At, B1); PG8_BAR; PG8_SCHED;
            PG8_LDA(At, 1, 1); PG8_STAGE(PG8_SB(1, 0), b3, voffB); PG8_STAGE(PG8_SB(1, 1), b3 + hstep, voffB); PG8_STAGE(PG8_SA(1, 0), a3, voffA);
            PG8_WAIT_V(8); PG8_WAIT_L(0); PG8_BAR; PG8_MMA(1, 0, At, B0); PG8_MMA(1, 1, At, B1); PG8_BAR; PG8_SCHED;
            } else {
            PG8_LDB(B0, 0, 0); PG8_SCHED; PG8_LDA(At, 0, 0); PG8_STAGE(PG8_SA(1, 1), a1 + hstep, voffA);
            PG8_WAIT_L(8); PG8_BAR; PG8_WAIT_L(0); PG8_MMA(0, 0, At, B0); PG8_BAR; PG8_SCHED;
            PG8_LDB(B1, 0, 1); PG8_STAGE(PG8_SB(0, 0), b2, voffB);
            PG8_BAR; PG8_WAIT_L(0); PG8_MMA(0, 1, At, B1); PG8_BAR;
            PG8_LDA(At, 0, 1); PG8_STAGE(PG8_SA(0, 0), a2, voffA);
            PG8_BAR; PG8_WAIT_L(0); PG8_MMA(1, 0, At, B0); PG8_BAR; PG8_SCHED;
            PG8_STAGE(PG8_SB(0, 1), b2 + hstep, voffB);
            PG8_WAIT_V(6); PG8_BAR; PG8_MMA(1, 1, At, B1); PG8_BAR;
            PG8_LDB(B0, 1, 0); PG8_SCHED; PG8_LDA(At, 1, 0); PG8_STAGE(PG8_SA(0, 1), a2 + hstep, voffA);
            PG8_WAIT_L(8); PG8_BAR; PG8_WAIT_L(0); PG8_MMA(0, 0, At, B0); PG8_BAR; PG8_SCHED;
            PG8_LDB(B1, 1, 1); PG8_STAGE(PG8_SB(1, 0), b3, voffB);
            PG8_BAR; PG8_WAIT_L(0); PG8_MMA(0, 1, At, B1); PG8_BAR;
            PG8_LDA(At, 1, 1); PG8_STAGE(PG8_SA(1, 0), a3, voffA);
            PG8_BAR; PG8_WAIT_L(0); PG8_MMA(1, 0, At, B0); PG8_BAR; PG8_SCHED;
            PG8_STAGE(PG8_SB(1, 1), b3 + hstep, voffB);
            PG8_WAIT_V(6); PG8_BAR; PG8_MMA(1, 1, At, B1); PG8_BAR;
            }
        }
        if constexpr (ALIGN_EPI) { if (wr == 0) PG8_BAR; }
        if constexpr (!Epi::AFTER_DRAIN) { E(acc, cur, wr, wc, fr, fq); S.done(cur); }
        if (!has_next) break;
#pragma unroll
        for (int a = 0; a < 2; ++a)
#pragma unroll
            for (int b = 0; b < 2; ++b)
#pragma unroll
                for (int m = 0; m < 4; ++m)
#pragma unroll
                    for (int n = 0; n < 2; ++n) acc[a][b][m][n] = (f32x4){0.f, 0.f, 0.f, 0.f};
        cur = nxt; cA = nA; cB = nB; ++ui;
        if constexpr (ALIGN_EPI) { if (wr == 1) PG8_BAR; }
    }
    PG8_WAIT_V(0);
    if constexpr (!ALIGN_EPI) { if (wr == 0) PG8_BAR; }
    PG8_BAR;
    if constexpr (Epi::AFTER_DRAIN) { E.fused(acc, cur, wr, wc, fr, fq, lds, wid, lane); S.done(cur); }
#undef PG8_SA
#undef PG8_SB
#undef PG8_STAGE
#undef PG8_LDA
#undef PG8_LDB
#undef PG8_MMA
#undef PG8_WAIT_V
#undef PG8_WAIT_L
#undef PG8_BAR
#undef PG8_SCHED
}
}

#define XB_TMO      128
#define XB_XCNT(j)  (256  + 64 * (j))
#define XB_XSUB(j)  (1280 + 64 * (j))
#define XB_XGEN(j)  (2304 + 64 * (j))
#define XB_TOP      3328
#define XB_TOPGEN   3392
#define XCD_BAR_WORDS 3456
#define XB_SPIN_CAP (1u << 18)

__device__ __forceinline__ unsigned xb_ld(unsigned* p)              { return __hip_atomic_load(p, __ATOMIC_RELAXED, __HIP_MEMORY_SCOPE_AGENT); }
__device__ __forceinline__ unsigned xb_add(unsigned* p, unsigned v) { return __hip_atomic_fetch_add(p, v, __ATOMIC_RELAXED, __HIP_MEMORY_SCOPE_AGENT); }
__device__ __forceinline__ unsigned xb_xcc_id() { return (unsigned)__builtin_amdgcn_s_getreg((3 << 11) | 20) & 0xFu; }
#define XB_SPIN(cond, bar) do { unsigned _sp = 0; while (cond) { __builtin_amdgcn_s_sleep(1); \
    if ((++_sp & 255u) == 0u) { if (xb_ld(&(bar)[XB_TMO])) break; if (_sp > XB_SPIN_CAP) { atomicAdd(&(bar)[XB_TMO], 1u); break; } } } } while (0)

struct XcdBarrier { unsigned* bar; unsigned x; volatile LAS unsigned* st; };

__device__ __forceinline__ XcdBarrier xcd_barrier_post(unsigned* bar, volatile LAS unsigned* st) {
    XcdBarrier b; b.bar = bar; b.x = xb_xcc_id(); b.st = st;
    if (threadIdx.x == 0) (void)xb_add(&bar[XB_XCNT(b.x)], 1u);
    return b;
}
__device__ __forceinline__ void xcd_barrier_complete(unsigned* bar, unsigned x, unsigned& nloc, unsigned& nx) {
    const unsigned G = gridDim.x * gridDim.y * gridDim.z;
    unsigned sum, cnt, mine, sp = 0u;
    for (;;) {
        sum = 0u; cnt = 0u; mine = 0u;
#pragma unroll
        for (unsigned j = 0; j < 16; ++j) { const unsigned c = xb_ld(&bar[XB_XCNT(j)]); sum += c; cnt += (c > 0u) ? 1u : 0u; mine = (j == x) ? c : mine; }
        if (sum == G) break;
        __builtin_amdgcn_s_sleep(1);
        if ((++sp & 255u) == 0u) { if (xb_ld(&bar[XB_TMO])) break; if (sp > XB_SPIN_CAP) { atomicAdd(&bar[XB_TMO], 1u); break; } }
    }
    nloc = mine > 0u ? mine : 1u; nx = cnt > 0u ? cnt : 1u;
}
__device__ __forceinline__ int lane_id_v() { int l_; asm volatile("v_mbcnt_lo_u32_b32 %0, -1, 0\n\tv_mbcnt_hi_u32_b32 %0, -1, %0" : "=v"(l_)); return l_; }
__device__ __forceinline__ void xcd_barrier(const XcdBarrier& b, int wave) {
    asm volatile("s_waitcnt vmcnt(0)" ::: "memory");
    __syncthreads();
    if (wave == 0 && lane_id_v() == 0) {
        unsigned* bar = b.bar;
        __builtin_amdgcn_s_waitcnt(0);
        unsigned nloc = b.st[0], nx = b.st[1];
        if (nloc == 0u) { xcd_barrier_complete(bar, b.x, nloc, nx); b.st[0] = nloc; b.st[1] = nx; }
        const unsigned old = xb_add(&bar[XB_XSUB(b.x)], 1u);
        const unsigned gen = old / nloc;
        if (old + 1u == (gen + 1u) * nloc) {
            __builtin_amdgcn_fence(__ATOMIC_RELEASE, "agent");
            asm volatile("s_waitcnt vmcnt(0)" ::: "memory");
            const unsigned og = xb_add(&bar[XB_TOP], 1u);
            const unsigned tg = og / nx;
            if (og + 1u == (tg + 1u) * nx) xb_add(&bar[XB_TOPGEN], 1u);
            else XB_SPIN(xb_ld(&bar[XB_TOPGEN]) == tg, bar);
            __builtin_amdgcn_fence(__ATOMIC_ACQUIRE, "agent");
            xb_add(&bar[XB_XGEN(b.x)], 1u);
            asm volatile("s_waitcnt vmcnt(0)" ::: "memory");
        } else {
            XB_SPIN(xb_ld(&bar[XB_XGEN(b.x)]) == gen, bar);
            __builtin_amdgcn_fence(__ATOMIC_ACQUIRE, "agent");
            asm volatile("s_waitcnt vmcnt(0)" ::: "memory");
        }
    }
    __syncthreads();
}

struct Frame {
    LAS unsigned char* lds;
    int tid, lane, wave;
    int vcu, G;
};

__device__ __forceinline__ float wave_sum(float v) {
#pragma unroll
    for (int o = 1; o < 64; o <<= 1) v += __shfl_xor(v, o);
    return v;
}

__device__ __forceinline__ void p0_tr_item(const float* src, size_t ld_src, bf16* dst, size_t ld_dst, int k0, int n0, LAS float* scr, int lane) {
#pragma unroll 8
    for (int i = 0; i < 32; ++i) { const int kk = 2 * i + (lane >> 5); scr[kk * 33 + (lane & 31)] = src[(size_t)(k0 + kk) * ld_src + n0 + (lane & 31)]; }
    LDS_WAIT(); asm volatile("" ::: "memory");
    const int c = lane & 7;
#pragma unroll
    for (int j = 0; j < 4; ++j) { const int n = (lane >> 3) + 8 * j; const LAS float* s = scr + (8 * c) * 33 + n;
        v4u o; o.x = pk2(s[0 * 33], s[1 * 33]); o.y = pk2(s[2 * 33], s[3 * 33]); o.z = pk2(s[4 * 33], s[5 * 33]); o.w = pk2(s[6 * 33], s[7 * 33]);
        *(GAS v4u*)(dst + (size_t)(n0 + n) * ld_dst + k0 + 8 * c) = o; }
    LDS_WAIT(); asm volatile("" ::: "memory");
}
__device__ __forceinline__ void p0_prologue(Frame& F) {
    KArgs ka = kargs(); unsigned char* const ws_p = ka->ws; float* const out_p = ka->out; const float* xp_ = ka->in[0]; const float* xs_ = ka->in[1]; const float* ck_ = ka->in[3]; const float* cv_ = ka->in[4]; const float* npre_ = ka->in[5]; const float* win_ = ka->in[6];
    const float* wpa_ = ka->in[10]; const float* wpb_ = ka->in[11]; const float* wo_ = ka->in[12];
    LAS float* scr = (LAS float*)(F.lds + F.wave * 16384);
    const int gw = F.vcu * NWAVES + F.wave, NGW = F.G * NWAVES;
    bf16* W1T = (bf16*)(ws_p + WS_W1T); bf16* W2T = (bf16*)(ws_p + WS_W2T); bf16* W3T = (bf16*)(ws_p + WS_W3T);
    bf16* KB = (bf16*)(ws_p + WS_KB); bf16* VB = (bf16*)(ws_p + WS_VB);
    constexpr int I1 = (DM / 64) * (DIN / 32), I2 = (1024 / 64) * (DM / 32), I3 = (DM / 64) * (DM / 32), I4 = DBATCH * HB * 16;
    constexpr int NITEMS = I1 + 2 * I2 + I3 + I4;
    for (int it = gw; it < NITEMS; it += NGW) {
        int r = it;
        if (r < I1) { const int nb = DIN / 32; p0_tr_item(win_, DIN, W1T, DM, 64 * (r / nb), 32 * (r % nb), scr, F.lane); continue; } r -= I1;
        if (r < I2) { const int nb = DM / 32; p0_tr_item(wpa_, DM, W2T, 2048, 64 * (r / nb), 32 * (r % nb), scr, F.lane); continue; } r -= I2;
        if (r < I2) { const int nb = DM / 32; p0_tr_item(wpb_, DM, W2T + 1024, 2048, 64 * (r / nb), 32 * (r % nb), scr, F.lane); continue; } r -= I2;
        if (r < I3) { const int nb = DM / 32; p0_tr_item(wo_, DM, W3T, DM, 64 * (r / nb), 32 * (r % nb), scr, F.lane); continue; } r -= I3;
        { const int sh = r >> 4, q = r & 15, sb = sh >> 4, h = sh & 15;
          p0_tr_item(cv_ + (size_t)sb * KVROWS * 1024 + h * 64, 1024, VB + KB_S + (size_t)sh * 64 * TS, TS, 64 * (q >> 1), 32 * (q & 1), scr, F.lane); }
    }
    { const int gt = gw * 64 + F.lane, NT = NGW * 64;
      for (int i = gt; i < DBATCH * KVROWS * 1024 / 8; i += NT) { const size_t e = (size_t)i * 8; const int sb = (int)(e >> 19), rem = (int)(e & 524287), t = rem >> 10, c = rem & 1023, h = c >> 6, d = c & 63;
          const f32x4 a = *(const GAS f32x4*)(ck_ + e), b = *(const GAS f32x4*)(ck_ + e + 4);
          v4u o; o.x = pk2(a.x, a.y); o.y = pk2(a.z, a.w); o.z = pk2(b.x, b.y); o.w = pk2(b.z, b.w);
          *(GAS v4u*)(KB + KB_S + (((size_t)(sb * 16 + h) * TS + t) * 64 + d)) = o; } }
    { bf16* XN = (bf16*)out_p; f32x4 g[8];
#pragma unroll
      for (int j = 0; j < 8; ++j) g[j] = ((const GAS f32x4*)npre_)[F.lane + 64 * j];
      for (int m = gw; m < M; m += NGW) { const float* xrow = m < MP ? xp_ + (size_t)m * DM : xs_ + (size_t)(m - MP) * DM;
          const GAS f32x4* xr = (const GAS f32x4*)xrow + F.lane; f32x4 v[8]; float s = 0.f;
#pragma unroll
          for (int j = 0; j < 8; ++j) { v[j] = xr[64 * j]; s += (v[j].x * v[j].x + v[j].y * v[j].y) + (v[j].z * v[j].z + v[j].w * v[j].w); }
          const float rstd = 1.0f / sqrtf(wave_sum(s) * (1.0f / DM) + EPS);
          GAS v2u* o8 = (GAS v2u*)(XN + (size_t)m * DM) + F.lane;
#pragma unroll
          for (int j = 0; j < 8; ++j) { v2u o; o.x = pk2(v[j].x * rstd * g[j].x, v[j].y * rstd * g[j].y); o.y = pk2(v[j].z * rstd * g[j].z, v[j].w * rstd * g[j].w); o8[64 * j] = o; } } }
}

constexpr int ATT_TBL_PITCH = 260, ATT_ST_OFF = 16 * ATT_TBL_PITCH * 4, ATT_ST_BYTES = 32 * 144;
template <bool SAMPLE_ONLY> __device__ __forceinline__ void attn_phase(Frame& F, const bool dummy = false) {
    typedef float f4 __attribute__((ext_vector_type(4)));
    LAS float* tbl = (LAS float*)F.lds; KArgs ka = kargs(); const float* rb_ = ka->in[9]; unsigned char* const ws_p = ka->ws;
    for (int i = F.tid; i < 16 * 257; i += NWAVES * 64) { const int h = i / 257, j = i % 257; tbl[h * ATT_TBL_PITCH + j] = rb_[i] * LOG2E; }
    __syncthreads();
    LAS unsigned char* st = F.lds + ATT_ST_OFF + F.wave * ATT_ST_BYTES;
    bf16* OAB = (bf16*)(ws_p + WS_OAB); const bf16* GB = (const bf16*)(ws_p + WS_GB);
    const bf16* KB = (const bf16*)(ws_p + WS_KB); const bf16* VB = (const bf16*)(ws_p + WS_VB);
    const int lane = F.lane, l15 = lane & 15, g = lane >> 4;
    const int gw = F.vcu * NWAVES + F.wave, NGW = F.G * NWAVES;
    constexpr int NWU = SAMPLE_ONLY ? DBATCH * HB * 2 : NCH * HB * 2;
    for (int wu = SAMPLE_ONLY ? (F.wave * F.G + F.vcu) : gw; wu < NWU; wu += NGW) {
        const int half = wu & 1, r = wu >> 1, gc = SAMPLE_ONLY ? 512 + (r & 15) : r % NCH, h = SAMPLE_ONLY ? (r >> 4) : r / NCH;
        const bf16* Kp; const bf16* Vp; int vpitch, kc0, kc1, cq;
        if (gc < 512) { const int b = gc >> 6, c = gc & 63; Kp = KB + (size_t)(b * 16 + h) * SEQ * 64; Vp = VB + (size_t)(b * 16 + h) * 64 * SEQ; vpitch = SEQ; cq = c; kc0 = c > 8 ? c - 8 : 0; kc1 = c; }
        else { const int sb = gc - 512; Kp = KB + KB_S + (size_t)(sb * 16 + h) * TS * 64; Vp = VB + KB_S + (size_t)(sb * 16 + h) * 64 * TS; vpitch = TS; cq = 8; kc0 = 0; kc1 = 8; }
        const size_t m0 = (size_t)gc * 64 + half * 32;
        bf16* Qg = OAB + m0 * 2048 + 1024 + h * 64;
        bf16x8 qf[2][2];
#pragma unroll
        for (int mb = 0; mb < 2; ++mb)
#pragma unroll
            for (int ks = 0; ks < 2; ++ks) qf[mb][ks] = *(const bf16x8*)(Qg + (size_t)(16 * mb + l15) * 2048 + 32 * ks + 8 * g);
        f4 o[2][4]; float mrun[2][4], lrun[2][4];
#pragma unroll
        for (int mb = 0; mb < 2; ++mb) {
#pragma unroll
            for (int nd = 0; nd < 4; ++nd) o[mb][nd] = (f4){0.f, 0.f, 0.f, 0.f};
#pragma unroll
            for (int j = 0; j < 4; ++j) { mrun[mb][j] = -1e30f; lrun[mb][j] = 0.f; } }
        const LAS float* tb = tbl + h * ATT_TBL_PITCH;
        bf16x8 kf[4][2];
#pragma unroll
        for (int nb = 0; nb < 4; ++nb)
#pragma unroll
            for (int ks = 0; ks < 2; ++ks) kf[nb][ks] = *(const bf16x8*)(Kp + (size_t)(kc0 * 64 + 16 * nb + l15) * 64 + 32 * ks + 8 * g);
        for (int kc = kc0; kc <= kc1; ++kc) {
            bf16x8 vf[4][2], kn[4][2];
#pragma unroll
            for (int nd = 0; nd < 4; ++nd)
#pragma unroll
                for (int ks = 0; ks < 2; ++ks) vf[nd][ks] = *(const bf16x8*)(Vp + (size_t)(16 * nd + l15) * vpitch + kc * 64 + 32 * ks + 8 * g);
            const int kcn = kc < kc1 ? kc + 1 : kc;
#pragma unroll
            for (int nb = 0; nb < 4; ++nb)
#pragma unroll
                for (int ks = 0; ks < 2; ++ks) kn[nb][ks] = *(const bf16x8*)(Kp + (size_t)(kcn * 64 + 16 * nb + l15) * 64 + 32 * ks + 8 * g);
            f4 s[2][4];
#pragma unroll
            for (int mb = 0; mb < 2; ++mb)
#pragma unroll
                for (int nb = 0; nb < 4; ++nb) { f4 a = (f4){0.f, 0.f, 0.f, 0.f};
                    a = __builtin_amdgcn_mfma_f32_16x16x32_bf16(qf[mb][0], kf[nb][0], a, 0, 0, 0);
                    a = __builtin_amdgcn_mfma_f32_16x16x32_bf16(qf[mb][1], kf[nb][1], a, 0, 0, 0); s[mb][nb] = a; }
            const int dlt = cq - kc;
            if (dlt >= 3) { const float cb = tb[256];
#pragma unroll
                for (int mb = 0; mb < 2; ++mb)
#pragma unroll
                    for (int nb = 0; nb < 4; ++nb) s[mb][nb] += cb;
            } else {
#pragma unroll
                for (int mb = 0; mb < 2; ++mb)
#pragma unroll
                    for (int nb = 0; nb < 4; ++nb)
#pragma unroll
                        for (int j = 0; j < 4; ++j) { int dist = 64 * dlt + (32 * half + 16 * mb + 4 * g + j) - (16 * nb + l15); dist = dist > 128 ? 128 : dist; s[mb][nb][j] += tb[128 + dist]; }
            }
#pragma unroll
            for (int mb = 0; mb < 2; ++mb)
#pragma unroll
                for (int j = 0; j < 4; ++j) {
                    float mx = fmaxf(fmaxf(s[mb][0][j], s[mb][1][j]), fmaxf(s[mb][2][j], s[mb][3][j]));
                    mx = fmaxf(mx, __shfl_xor(mx, 1)); mx = fmaxf(mx, __shfl_xor(mx, 2)); mx = fmaxf(mx, __shfl_xor(mx, 4)); mx = fmaxf(mx, __shfl_xor(mx, 8));
                    const float mn = fmaxf(mrun[mb][j], mx), al = __builtin_amdgcn_exp2f(mrun[mb][j] - mn); mrun[mb][j] = mn;
                    float ps = 0.f;
#pragma unroll
                    for (int nb = 0; nb < 4; ++nb) { const float p = __builtin_amdgcn_exp2f(s[mb][nb][j] - mn); s[mb][nb][j] = p; ps += p; }
                    lrun[mb][j] = lrun[mb][j] * al + ps;
#pragma unroll
                    for (int nd = 0; nd < 4; ++nd) o[mb][nd][j] *= al;
                }
#pragma unroll
            for (int mb = 0; mb < 2; ++mb)
#pragma unroll
                for (int nb = 0; nb < 4; ++nb)
#pragma unroll
                    for (int j = 0; j < 4; ++j) *(LAS bf16*)(st + (16 * mb + 4 * g + j) * 144 + (16 * nb + l15) * 2) = (bf16)f2bf(s[mb][nb][j]);
            bf16x8 pf[2][2];
#pragma unroll
            for (int mb = 0; mb < 2; ++mb)
#pragma unroll
                for (int ks = 0; ks < 2; ++ks) pf[mb][ks] = *(const LAS bf16x8*)(st + (16 * mb + l15) * 144 + (32 * ks + 8 * g) * 2);
#pragma unroll
            for (int mb = 0; mb < 2; ++mb)
#pragma unroll
                for (int nd = 0; nd < 4; ++nd) {
                    o[mb][nd] = __builtin_amdgcn_mfma_f32_16x16x32_bf16(pf[mb][0], vf[nd][0], o[mb][nd], 0, 0, 0);
                    o[mb][nd] = __builtin_amdgcn_mfma_f32_16x16x32_bf16(pf[mb][1], vf[nd][1], o[mb][nd], 0, 0, 0); }
#pragma unroll
            for (int nb = 0; nb < 4; ++nb)
#pragma unroll
                for (int ks = 0; ks < 2; ++ks) kf[nb][ks] = kn[nb][ks];
        }
#pragma unroll
        for (int mb = 0; mb < 2; ++mb)
#pragma unroll
            for (int j = 0; j < 4; ++j) { float l = lrun[mb][j]; l += __shfl_xor(l, 1); l += __shfl_xor(l, 2); l += __shfl_xor(l, 4); l += __shfl_xor(l, 8); const float rl = 1.0f / l;
#pragma unroll
                for (int nd = 0; nd < 4; ++nd) *(LAS bf16*)(st + (16 * mb + 4 * g + j) * 144 + (16 * nd + l15) * 2) = (bf16)f2bf(o[mb][nd][j] * rl); }
#pragma unroll
        for (int it = 0; it < 4; ++it) { const int row = it * 8 + (lane >> 3), oc = lane & 7;
            const v4u ov = *(const LAS v4u*)(st + row * 144 + oc * 16);
            const v4u gv = *(const GAS v4u*)(GB + (m0 + row) * 1024 + h * 64 + oc * 8);
            v4u w; w.x = pk2(bflo(ov.x) * bflo(gv.x), bfhi(ov.x) * bfhi(gv.x)); w.y = pk2(bflo(ov.y) * bflo(gv.y), bfhi(ov.y) * bfhi(gv.y));
            w.z = pk2(bflo(ov.z) * bflo(gv.z), bfhi(ov.z) * bfhi(gv.z)); w.w = pk2(bflo(ov.w) * bflo(gv.w), bfhi(ov.w) * bfhi(gv.w));
            if (dummy) *(GAS v4u*)((bf16*)(ws_p + 897 * MiB) + (m0 + row) * 1024 + h * 64 + oc * 8) = w; else *(GAS v4u*)(Qg + (size_t)row * 2048 + oc * 8) = w; }
    }
}

constexpr int A2_RING = ATT_ST_OFF, A2_KT = 64 * 144, A2_SLOT = 2 * A2_KT;
static_assert(A2_RING + 2 * A2_SLOT <= MISC_OFF, "attention LDS map");
__device__ __forceinline__ float xhalf_max(float x) { auto r = __builtin_amdgcn_permlane32_swap(__float_as_uint(x), __float_as_uint(x), false, false); return fmaxf(__uint_as_float(r[0]), __uint_as_float(r[1])); }
__device__ __forceinline__ float xhalf_sum(float x) { auto r = __builtin_amdgcn_permlane32_swap(__float_as_uint(x), __float_as_uint(x), false, false); return __uint_as_float(r[0]) + __uint_as_float(r[1]); }
__device__ __forceinline__ void attn2_phase(Frame& F) {
    KArgs ka = kargs(); unsigned char* const ws_p = ka->ws;
    LAS unsigned char* L = F.lds; const LAS float* tbl = (const LAS float*)L;
    bf16* OAB = (bf16*)(ws_p + WS_OAB); const bf16* GB = (const bf16*)(ws_p + WS_GB); const bf16* KB = (const bf16*)(ws_p + WS_KB); const bf16* VB = (const bf16*)(ws_p + WS_VB);
    const int tid = F.tid, lane = F.lane, w = F.wave, r32 = lane & 31, hh = lane >> 5;
    const int srow = tid >> 3, sc16 = tid & 7;
    const int pr = (r32 & ~12) | ((r32 & 4) << 1) | ((r32 & 8) >> 1);
    for (int uid = F.vcu; uid < NBATCH * HB * 16; uid += F.G) {
        const int j = uid >> 7, bh = uid & 127, b = bh >> 4, h = bh & 15;
        const int c = 4 * j + (w >> 1), half = w & 1, lo = c > 8 ? c - 8 : 0, hi = c;
        const int kt0 = j > 2 ? 4 * j - 8 : 0, kt1 = 4 * j + 3;
        const size_t m0 = (size_t)(b * 64 + c) * 64 + 32 * half;
        const bf16* Kg = KB + (size_t)bh * SEQ * 64 + srow * 64 + sc16 * 8;
        const bf16* Vg = VB + ((size_t)bh * 64 + srow) * SEQ + sc16 * 8;
        bf16x8 qf[4];
#pragma unroll
        for (int ks = 0; ks < 4; ++ks) qf[ks] = *(const bf16x8*)(OAB + (m0 + r32) * 2048 + 1024 + h * 64 + 16 * ks + 8 * hh);
        { const v4u k0 = *(const v4u*)(Kg + (size_t)kt0 * 4096), v0 = *(const v4u*)(Vg + kt0 * 64);
          *(LAS v4u*)(L + A2_RING + srow * 144 + sc16 * 16) = k0; *(LAS v4u*)(L + A2_RING + A2_KT + srow * 144 + sc16 * 16) = v0; }
        __syncthreads();
        f32x16 ot[2]; ot[0] = f32x16{}; ot[1] = f32x16{}; float mrun = -1e30f, lrun = 0.f;
        const LAS float* tb = tbl + h * ATT_TBL_PITCH; const int qi = 32 * half + r32;
        for (int kc = kt0; kc <= kt1; ++kc) {
            const int slot = (kc - kt0) & 1; const LAS unsigned char* Ks = L + A2_RING + slot * A2_SLOT; const LAS unsigned char* Vs = Ks + A2_KT;
            v4u kn = {}, vn = {};
            if (kc < kt1) { kn = *(const v4u*)(Kg + (size_t)(kc + 1) * 4096); vn = *(const v4u*)(Vg + (kc + 1) * 64); }
            if (kc >= lo && kc <= hi) {
                f32x16 st[2];
#pragma unroll
                for (int blk = 0; blk < 2; ++blk) { st[blk] = f32x16{};
#pragma unroll
                    for (int ks = 0; ks < 4; ++ks) { const bf16x8 a = *(const LAS bf16x8*)(Ks + (32 * blk + pr) * 144 + (16 * ks + 8 * hh) * 2); st[blk] = __builtin_amdgcn_mfma_f32_32x32x16_bf16(a, qf[ks], st[blk], 0, 0, 0); } }
                const int dlt = c - kc;
                if (dlt >= 3) { const float cb = tb[256];
#pragma unroll
                    for (int blk = 0; blk < 2; ++blk)
#pragma unroll
                        for (int e = 0; e < 16; ++e) st[blk][e] += cb;
                } else { const int base = 128 + 64 * dlt + qi - 8 * hh;
#pragma unroll
                    for (int blk = 0; blk < 2; ++blk)
#pragma unroll
                        for (int e = 0; e < 16; ++e) { int idx = base - (32 * blk + 16 * (e >> 3) + (e & 7)); idx = idx > 256 ? 256 : idx; st[blk][e] += tb[idx]; } }
                float mx = st[0][0];
#pragma unroll
                for (int e = 1; e < 16; ++e) mx = fmaxf(mx, st[0][e]);
#pragma unroll
                for (int e = 0; e < 16; ++e) mx = fmaxf(mx, st[1][e]);
                mx = xhalf_max(mx);
                const float mn = fmaxf(mrun, mx), al = __builtin_amdgcn_exp2f(mrun - mn); mrun = mn;
                float ps = 0.f;
#pragma unroll
                for (int blk = 0; blk < 2; ++blk)
#pragma unroll
                    for (int e = 0; e < 16; ++e) { const float p = __builtin_amdgcn_exp2f(st[blk][e] - mn); st[blk][e] = p; ps += p; }
                lrun = lrun * al + ps;
#pragma unroll
                for (int db = 0; db < 2; ++db)
#pragma unroll
                    for (int e = 0; e < 16; ++e) ot[db][e] *= al;
#pragma unroll
                for (int blk = 0; blk < 2; ++blk)
#pragma unroll
                    for (int sx = 0; sx < 2; ++sx) {
                        v4u pw; pw.x = pk2(st[blk][8 * sx], st[blk][8 * sx + 1]); pw.y = pk2(st[blk][8 * sx + 2], st[blk][8 * sx + 3]); pw.z = pk2(st[blk][8 * sx + 4], st[blk][8 * sx + 5]); pw.w = pk2(st[blk][8 * sx + 6], st[blk][8 * sx + 7]);
                        const bf16x8 pf = __builtin_bit_cast(bf16x8, pw);
#pragma unroll
                        for (int db = 0; db < 2; ++db) { const bf16x8 a = *(const LAS bf16x8*)(Vs + (32 * db + r32) * 144 + (32 * blk + 16 * sx + 8 * hh) * 2); ot[db] = __builtin_amdgcn_mfma_f32_32x32x16_bf16(a, pf, ot[db], 0, 0, 0); } }
            }
            if (kc < kt1) { LAS unsigned char* Kd = L + A2_RING + (slot ^ 1) * A2_SLOT; *(LAS v4u*)(Kd + srow * 144 + sc16 * 16) = kn; *(LAS v4u*)(Kd + A2_KT + srow * 144 + sc16 * 16) = vn; }
            __syncthreads();
        }
        const float inv = 1.0f / xhalf_sum(lrun);
#pragma unroll
        for (int db = 0; db < 2; ++db)
#pragma unroll
            for (int g = 0; g < 4; ++g) { const int d0 = 32 * db + 8 * g + 4 * hh;
                const v2u gv = *(const GAS v2u*)(GB + (m0 + r32) * 1024 + h * 64 + d0);
                v2u o; o.x = pk2(ot[db][4 * g] * inv * bflo(gv.x), ot[db][4 * g + 1] * inv * bfhi(gv.x)); o.y = pk2(ot[db][4 * g + 2] * inv * bflo(gv.y), ot[db][4 * g + 3] * inv * bfhi(gv.y));
                *(GAS v2u*)(OAB + (m0 + r32) * 2048 + 1024 + h * 64 + d0) = o; }
    }
}

constexpr int HF_OFF = 0, HV_OFF = 32768, HQ_OFF = 66048, HO_OFF = 98816;
template <int MODE> __device__ __forceinline__ void hgrn_phase(Frame& F) {
    LAS float* Fs = (LAS float*)(F.lds + HF_OFF); LAS float* Vs = (LAS float*)(F.lds + HV_OFF); LAS float* Qs = (LAS float*)(F.lds + HQ_OFF); LAS float* O2 = (LAS float*)(F.lds + HO_OFF);
    const int tid = F.tid, lane = F.lane, w = F.wave; KArgs ka = kargs(); const float* gn_ = ka->in[8]; unsigned char* const ws_p = ka->ws; float* const out_p = ka->out;
    const bf16* LF = (const bf16*)(ws_p + WS_LF); const bf16* VA = (const bf16*)(ws_p + WS_VA); const bf16* GA = (const bf16*)(ws_p + WS_GA);
    bf16* OAB = (bf16*)(ws_p + WS_OAB); const bf16* ST = (const bf16*)(ws_p + WS_ST); float* DD = (float*)(ws_p + WS_DD); float* UT = out_p;
    const int dv = 32 * (w & 3) + (lane & 31), kq = (lane >> 5) + 2 * (w >> 2);
    for (int u = F.vcu; u < NUNIT; u += F.G) {
        const int gc = u >> 3, h = u & 7; const size_t m0 = (size_t)gc * 64; const size_t ub = (size_t)u * 8192;
#pragma unroll 4
        for (int i = 0; i < 16; ++i) { const int e = tid + 512 * i; Fs[e] = __expf(h2f(LF[ub + e]));
            if (MODE == 1) { const int t = e >> 7, k = e & 127; Qs[e] = bf2f(OAB[(m0 + t) * 2048 + h * 128 + k]); O2[e] = 0.f; } }
#pragma unroll 4
        for (int i = 0; i < 16; ++i) { const int e = tid + 512 * i; Vs[(e & 63) * 129 + (e >> 6)] = bf2f(VA[ub + e]); }
        if (MODE == 0 && tid < 128) { float s = 0.f;
#pragma unroll 8
            for (int t = 0; t < 64; ++t) s += h2f(LF[ub + t * 128 + tid]);
            DD[(size_t)u * 128 + tid] = __expf(s); }
        __syncthreads();
        float S[32];
        if (MODE == 1) { const v4u* sp = (const v4u*)(ST + (size_t)u * 16384 + dv * 128 + 32 * kq);
#pragma unroll
            for (int i = 0; i < 4; ++i) { const v4u x = sp[i]; S[8 * i + 0] = bflo(x.x); S[8 * i + 1] = bfhi(x.x); S[8 * i + 2] = bflo(x.y); S[8 * i + 3] = bfhi(x.y); S[8 * i + 4] = bflo(x.z); S[8 * i + 5] = bfhi(x.z); S[8 * i + 6] = bflo(x.w); S[8 * i + 7] = bfhi(x.w); }
        } else {
#pragma unroll
            for (int i = 0; i < 32; ++i) S[i] = 0.f; }
#pragma unroll 2
        for (int t = 0; t < 64; ++t) {
            const float v = Vs[t * 129 + dv]; float o = 0.f;
            const LAS f32x4* fp = (const LAS f32x4*)(Fs + t * 128 + 32 * kq); const LAS f32x4* qp = (const LAS f32x4*)(Qs + t * 128 + 32 * kq);
#pragma unroll
            for (int k4 = 0; k4 < 8; ++k4) { const f32x4 f = fp[k4];
#pragma unroll
                for (int e = 0; e < 4; ++e) S[4 * k4 + e] = f[e] * (S[4 * k4 + e] - v) + v;
                if (MODE == 1) { const f32x4 q = qp[k4];
#pragma unroll
                    for (int e = 0; e < 4; ++e) o += q[e] * S[4 * k4 + e]; } }
            if (MODE == 1) { o += __shfl_xor(o, 32); if (lane < 32) atomicAdd((float*)(O2 + t * 128 + dv), o); }
        }
        if (MODE == 0) { f32x4* up = (f32x4*)(UT + (size_t)u * 16384 + dv * 128 + 32 * kq);
#pragma unroll
            for (int i = 0; i < 8; ++i) up[i] = (f32x4){S[4 * i], S[4 * i + 1], S[4 * i + 2], S[4 * i + 3]};
        } else {
            __syncthreads();
            const int t = tid >> 3, sg = tid & 7; float ov[16]; float ss = 0.f;
#pragma unroll
            for (int e = 0; e < 16; ++e) { ov[e] = O2[t * 128 + 16 * sg + e]; ss += ov[e] * ov[e]; }
            ss += __shfl_xor(ss, 1); ss += __shfl_xor(ss, 2); ss += __shfl_xor(ss, 4);
            const float rstd = 1.0f / sqrtf(ss * (1.0f / 128.0f) + EPS);
            const v4u g0 = *(const v4u*)(GA + ub + t * 128 + 16 * sg), g1 = *(const v4u*)(GA + ub + t * 128 + 16 * sg + 8);
            const float* gn = gn_ + h * 128 + 16 * sg;
            float ga[16] = {bflo(g0.x), bfhi(g0.x), bflo(g0.y), bfhi(g0.y), bflo(g0.z), bfhi(g0.z), bflo(g0.w), bfhi(g0.w), bflo(g1.x), bfhi(g1.x), bflo(g1.y), bfhi(g1.y), bflo(g1.z), bfhi(g1.z), bflo(g1.w), bfhi(g1.w)};
            unsigned pw[8];
#pragma unroll
            for (int e = 0; e < 8; ++e) pw[e] = pk2(ov[2 * e] * rstd * gn[2 * e] * ga[2 * e], ov[2 * e + 1] * rstd * gn[2 * e + 1] * ga[2 * e + 1]);
            v4u* op = (v4u*)(OAB + (m0 + t) * 2048 + h * 128 + 16 * sg);
            op[0] = (v4u){pw[0], pw[1], pw[2], pw[3]}; op[1] = (v4u){pw[4], pw[5], pw[6], pw[7]};
        }
        __syncthreads();
    }
}
constexpr int HP = 136, HP64 = 72;
constexpr int L_TAU = 0, L_QT = 4096, L_QG = L_QT + 64 * HP * 2, L_KH = L_QG + 64 * HP * 2, L_VT = L_KH + 160 * HP * 2, L_ST = L_VT + 128 * HP64 * 2, L_A = L_ST + 128 * HP * 2, L_HEND = L_A + 64 * HP64 * 2;
constexpr int L_O2 = L_KH;
static_assert(L_HEND <= MISC_OFF && 64 * 128 * 4 <= 160 * HP * 2, "HGRN LDS map");
template <int MODE> __device__ __forceinline__ void hgrn_mfma_phase(Frame& F) {
    KArgs ka = kargs(); const float* gn_ = ka->in[8]; unsigned char* const ws_p = ka->ws; float* const out_p = ka->out;
    const bf16* LF = (const bf16*)(ws_p + WS_LF); const bf16* VA = (const bf16*)(ws_p + WS_VA); const bf16* GA = (const bf16*)(ws_p + WS_GA);
    bf16* OAB = (bf16*)(ws_p + WS_OAB); const bf16* ST = (const bf16*)(ws_p + WS_ST); float* DD = (float*)(ws_p + WS_DD); float* UT = out_p;
    LAS unsigned char* L = F.lds;
    const int tid = F.tid, lane = F.lane, w = F.wave, kp = lane, tg = w;
    for (int u = F.vcu; u < NUNIT; u += F.G) {
        const int gc = u >> 3, h = u & 7; const size_t m0 = (size_t)gc * 64; const size_t ub = (size_t)u * 8192;
        unsigned gw[8], qw[8];
#pragma unroll
        for (int j = 0; j < 8; ++j) gw[j] = *(const unsigned*)(LF + ub + (8 * tg + j) * 128 + 2 * kp);
        if (MODE == 1) {
#pragma unroll
            for (int j = 0; j < 8; ++j) qw[j] = *(const unsigned*)(OAB + (m0 + 8 * tg + j) * 2048 + h * 128 + 2 * kp); }
        { const v4u* vp = (const v4u*)(VA + ub + tid * 16); const v4u a = vp[0], b = vp[1];
          LAS v4u* d = (LAS v4u*)(L + L_VT + ((tid >> 2) * HP64 + (tid & 3) * 16) * 2); d[0] = a; d[1] = b; }
        if (MODE == 1) { const v4u* sp = (const v4u*)(ST + (size_t)u * 16384 + tid * 32); const v4u a = sp[0], b = sp[1], c = sp[2], e = sp[3];
          LAS v4u* d = (LAS v4u*)(L + L_ST + ((tid >> 2) * HP + (tid & 3) * 32) * 2); d[0] = a; d[1] = b; d[2] = c; d[3] = e; }
        float g0[8], g1[8], c0[8], c1[8]; float a0 = 0.f, a1 = 0.f;
#pragma unroll
        for (int j = 0; j < 8; ++j) { g0[j] = h2f((unsigned short)(gw[j] & 0xffffu)); g1[j] = h2f((unsigned short)(gw[j] >> 16)); a0 += g0[j]; a1 += g1[j]; c0[j] = a0; c1[j] = a1; }
        *(LAS f32x2_g*)(L + L_TAU + (tg * 128 + 2 * kp) * 4) = (f32x2_g){a0, a1};
        __syncthreads();
        float P0[9], P1[9]; P0[0] = 0.f; P1[0] = 0.f;
#pragma unroll
        for (int gq = 0; gq < 8; ++gq) { const f32x2_g t2 = *(const LAS f32x2_g*)(L + L_TAU + (gq * 128 + 2 * kp) * 4); P0[gq + 1] = P0[gq] + t2.x; P1[gq + 1] = P1[gq] + t2.y; }
        float pb0 = 0.f, pb1 = 0.f;
#pragma unroll
        for (int gq = 0; gq < 8; ++gq) if (gq == tg) { pb0 = P0[gq]; pb1 = P1[gq]; }
        if (MODE == 0) {
            const float bl0 = P0[8], bl1 = P1[8]; unsigned k0w[4], k1w[4];
#pragma unroll
            for (int j = 0; j < 8; j += 2) {
                const float x00 = (1.0f - __expf(g0[j])) * __expf(bl0 - (pb0 + c0[j])), x01 = (1.0f - __expf(g0[j + 1])) * __expf(bl0 - (pb0 + c0[j + 1]));
                const float x10 = (1.0f - __expf(g1[j])) * __expf(bl1 - (pb1 + c1[j])), x11 = (1.0f - __expf(g1[j + 1])) * __expf(bl1 - (pb1 + c1[j + 1]));
                k0w[j >> 1] = pk2(x00, x01); k1w[j >> 1] = pk2(x10, x11); }
            *(LAS v4u*)(L + L_KH + ((2 * kp) * HP64 + 8 * tg) * 2) = (v4u){k0w[0], k0w[1], k0w[2], k0w[3]};
            *(LAS v4u*)(L + L_KH + ((2 * kp + 1) * HP64 + 8 * tg) * 2) = (v4u){k1w[0], k1w[1], k1w[2], k1w[3]};
            if (tg == 0) *(f32x2_g*)(DD + (size_t)u * 128 + 2 * kp) = (f32x2_g){__expf(bl0), __expf(bl1)};
        } else {
            const int si = tg >> 1; float be0[4], be1[4];
#pragma unroll
            for (int ii = 0; ii < 4; ++ii) { be0[ii] = P0[2 * ii]; be1[ii] = P1[2 * ii]; }
            float bi0 = 0.f, bi1 = 0.f;
#pragma unroll
            for (int ii = 0; ii < 4; ++ii) if (ii == si) { bi0 = be0[ii]; bi1 = be1[ii]; }
#pragma unroll
            for (int j = 0; j < 8; ++j) { const int t = 8 * tg + j;
                const float b0 = pb0 + c0[j], b1 = pb1 + c1[j], q0 = bflo(qw[j]), q1 = bfhi(qw[j]);
                *(LAS unsigned*)(L + L_QT + (t * HP + 2 * kp) * 2) = pk2(q0 * __expf(b0 - bi0), q1 * __expf(b1 - bi1));
                *(LAS unsigned*)(L + L_QG + (t * HP + 2 * kp) * 2) = pk2(q0 * __expf(b0), q1 * __expf(b1));
                const float kv0 = 1.0f - __expf(g0[j]), kv1 = 1.0f - __expf(g1[j]);
#pragma unroll
                for (int ii = 0; ii < 4; ++ii) if (ii >= si) {
                    *(LAS unsigned*)(L + L_KH + ((8 * ii * (ii + 1) + t) * HP + 2 * kp) * 2) = pk2(kv0 * __expf(be0[ii] - b0), kv1 * __expf(be1[ii] - b1)); } }
        }
        __syncthreads();
        const int r32 = lane & 31, hh = lane >> 5, l15 = lane & 15, g4 = lane >> 4;
        if (MODE == 0) {
#pragma unroll
            for (int ti = 0; ti < 2; ++ti) { const int T2 = 2 * w + ti, kb = T2 >> 2, db = T2 & 3; f32x16 acc = {};
#pragma unroll
                for (int ks = 0; ks < 4; ++ks) { const bf16x8 a = *(const LAS bf16x8*)(L + L_KH + ((32 * kb + r32) * HP64 + 16 * ks + 8 * hh) * 2), b = *(const LAS bf16x8*)(L + L_VT + ((32 * db + r32) * HP64 + 16 * ks + 8 * hh) * 2);
                    acc = __builtin_amdgcn_mfma_f32_32x32x16_bf16(a, b, acc, 0, 0, 0); }
                float* up = UT + (size_t)u * 16384 + (32 * db + r32) * 128 + 32 * kb + 4 * hh;
#pragma unroll
                for (int q4 = 0; q4 < 4; ++q4) *(f32x4*)(up + 8 * q4) = (f32x4){acc[4 * q4], acc[4 * q4 + 1], acc[4 * q4 + 2], acc[4 * q4 + 3]}; }
        } else {
#pragma unroll
            for (int bi = 0; bi < 2; ++bi) { const int blk = w + 8 * bi; if (blk < 10) {
                const int i = blk < 1 ? 0 : blk < 3 ? 1 : blk < 6 ? 2 : 3, j = blk - (i * (i + 1)) / 2; f32x4 acc = {};
#pragma unroll
                for (int ks = 0; ks < 4; ++ks) { const bf16x8 a = *(const LAS bf16x8*)(L + L_QT + ((16 * i + l15) * HP + 32 * ks + 8 * g4) * 2), b = *(const LAS bf16x8*)(L + L_KH + ((8 * i * (i + 1) + 16 * j + l15) * HP + 32 * ks + 8 * g4) * 2);
                    acc = __builtin_amdgcn_mfma_f32_16x16x32_bf16(a, b, acc, 0, 0, 0); }
#pragma unroll
                for (int e = 0; e < 4; ++e) { const int t = 16 * i + 4 * g4 + e, s = 16 * j + l15; *(LAS bf16*)(L + L_A + (t * HP64 + s) * 2) = (bf16)f2bf((i == j && s > t) ? 0.f : acc[e]); } } }
            if (w >= 2) { const int z = w - 2, i = z < 3 ? 0 : z < 5 ? 1 : 2, j = z < 3 ? z + 1 : z < 5 ? z - 1 : 3;
#pragma unroll
                for (int e = 0; e < 4; ++e) *(LAS bf16*)(L + L_A + ((16 * i + 4 * g4 + e) * HP64 + 16 * j + l15) * 2) = (bf16)0; }
            __syncthreads();
            { const int tb = w >> 2, db = w & 3; f32x16 acc = {};
#pragma unroll
              for (int ks = 0; ks < 8; ++ks) { const bf16x8 a = *(const LAS bf16x8*)(L + L_QG + ((32 * tb + r32) * HP + 16 * ks + 8 * hh) * 2), b = *(const LAS bf16x8*)(L + L_ST + ((32 * db + r32) * HP + 16 * ks + 8 * hh) * 2);
                  acc = __builtin_amdgcn_mfma_f32_32x32x16_bf16(a, b, acc, 0, 0, 0); }
#pragma unroll
              for (int ks = 0; ks < 4; ++ks) { const bf16x8 a = *(const LAS bf16x8*)(L + L_A + ((32 * tb + r32) * HP64 + 16 * ks + 8 * hh) * 2), b = *(const LAS bf16x8*)(L + L_VT + ((32 * db + r32) * HP64 + 16 * ks + 8 * hh) * 2);
                  acc = __builtin_amdgcn_mfma_f32_32x32x16_bf16(a, b, acc, 0, 0, 0); }
#pragma unroll
              for (int e = 0; e < 16; ++e) *(LAS float*)(L + L_O2 + ((32 * tb + (e & 3) + 8 * (e >> 2) + 4 * hh) * 128 + 32 * db + r32) * 4) = acc[e]; }
            __syncthreads();
            const LAS float* O2 = (const LAS float*)(L + L_O2);
            const int t = tid >> 3, sg = tid & 7; float ov[16]; float ss = 0.f;
#pragma unroll
            for (int e = 0; e < 16; ++e) { ov[e] = O2[t * 128 + 16 * sg + e]; ss += ov[e] * ov[e]; }
            ss += __shfl_xor(ss, 1); ss += __shfl_xor(ss, 2); ss += __shfl_xor(ss, 4);
            const float rstd = 1.0f / sqrtf(ss * (1.0f / 128.0f) + EPS);
            const v4u ga0 = *(const v4u*)(GA + ub + t * 128 + 16 * sg), ga1 = *(const v4u*)(GA + ub + t * 128 + 16 * sg + 8);
            const float* gn = gn_ + h * 128 + 16 * sg;
            float ga[16] = {bflo(ga0.x), bfhi(ga0.x), bflo(ga0.y), bfhi(ga0.y), bflo(ga0.z), bfhi(ga0.z), bflo(ga0.w), bfhi(ga0.w), bflo(ga1.x), bfhi(ga1.x), bflo(ga1.y), bfhi(ga1.y), bflo(ga1.z), bfhi(ga1.z), bflo(ga1.w), bfhi(ga1.w)};
            unsigned pw[8];
#pragma unroll
            for (int e = 0; e < 8; ++e) pw[e] = pk2(ov[2 * e] * rstd * gn[2 * e] * ga[2 * e], ov[2 * e + 1] * rstd * gn[2 * e + 1] * ga[2 * e + 1]);
            v4u* op = (v4u*)(OAB + (m0 + t) * 2048 + h * 128 + 16 * sg);
            op[0] = (v4u){pw[0], pw[1], pw[2], pw[3]}; op[1] = (v4u){pw[4], pw[5], pw[6], pw[7]};
        }
        __syncthreads();
    }
}
__device__ __forceinline__ void scan_phase(Frame& F) {
    KArgs ka = kargs(); const float* state_ = ka->in[2]; unsigned char* const ws_p = ka->ws; float* const out_p = ka->out;
    const int gt = F.vcu * 512 + F.tid, NT = F.G * 512;
    const float* UT = out_p; const float* DD = (const float*)(ws_p + WS_DD); bf16* ST = (bf16*)(ws_p + WS_ST);
    for (int item = gt; item < 64 * 128 * 16; item += NT) {
        const int ko = item & 15, dv = (item >> 4) & 127, sh = item >> 11, b = sh >> 3, h = sh & 7;
        float S[8];
#pragma unroll
        for (int e = 0; e < 8; ++e) S[e] = 0.f;
#pragma unroll 4
        for (int c = 0; c < 64; ++c) { const size_t u = (size_t)((b * 64 + c) * 8 + h);
            const f32x4 u0 = *(const f32x4*)(UT + u * 16384 + dv * 128 + 8 * ko), u1 = *(const f32x4*)(UT + u * 16384 + dv * 128 + 8 * ko + 4);
            const f32x4 d0 = *(const f32x4*)(DD + u * 128 + 8 * ko), d1 = *(const f32x4*)(DD + u * 128 + 8 * ko + 4);
            *(v4u*)(ST + u * 16384 + dv * 128 + 8 * ko) = (v4u){pk2(S[0], S[1]), pk2(S[2], S[3]), pk2(S[4], S[5]), pk2(S[6], S[7])};
#pragma unroll
            for (int e = 0; e < 4; ++e) { S[e] = d0[e] * S[e] + u0[e]; S[4 + e] = d1[e] * S[4 + e] + u1[e]; } }
#pragma unroll
        for (int e = 0; e < 8; ++e) out_p[O_SP + ((size_t)(sh * 128 + 8 * ko + e) * 128 + dv)] = S[e];
    }
    for (int item = gt; item < 128 * 128 * 16; item += NT) {
        const int ko = item & 15, dv = (item >> 4) & 127, ssh = item >> 11, sb = ssh >> 3, h = ssh & 7; const size_t u = (size_t)((512 + sb) * 8 + h);
        float S[8];
#pragma unroll
        for (int e = 0; e < 8; ++e) S[e] = state_[((size_t)(ssh * 128 + 8 * ko + e) * 128 + dv)];
        const f32x4 u0 = *(const f32x4*)(UT + u * 16384 + dv * 128 + 8 * ko), u1 = *(const f32x4*)(UT + u * 16384 + dv * 128 + 8 * ko + 4);
        const f32x4 d0 = *(const f32x4*)(DD + u * 128 + 8 * ko), d1 = *(const f32x4*)(DD + u * 128 + 8 * ko + 4);
        *(v4u*)(ST + u * 16384 + dv * 128 + 8 * ko) = (v4u){pk2(S[0], S[1]), pk2(S[2], S[3]), pk2(S[4], S[5]), pk2(S[6], S[7])};
#pragma unroll
        for (int e = 0; e < 4; ++e) { S[e] = d0[e] * S[e] + u0[e]; S[4 + e] = d1[e] * S[4 + e] + u1[e]; }
#pragma unroll
        for (int e = 0; e < 8; ++e) out_p[O_SS + ((size_t)(ssh * 128 + 8 * ko + e) * 128 + dv)] = S[e];
    }
}
__device__ __forceinline__ void final_phase(Frame& F) {
    KArgs ka = kargs(); unsigned char* const ws_p = ka->ws; float* const out_p = ka->out;
    const bf16* UO = (const bf16*)(ws_p + WS_UO); const float* SQ = (const float*)(ws_p + WS_SQ);
    const int gw = F.vcu * NWAVES + F.wave, NGW = F.G * NWAVES, lane = F.lane; const float* xp_ = ka->in[0]; const float* xs_ = ka->in[1]; const float* npost_ = ka->in[13];
    for (int m = gw; m < M; m += NGW) {
        const float sq = wave_sum(lane < 32 ? SQ[(size_t)m * 32 + lane] : 0.f);
        const float rstd = 1.0f / sqrtf(sq * (1.0f / DM) + EPS);
        const float* xrow = m < MP ? xp_ + (size_t)m * DM : xs_ + (size_t)(m - MP) * DM;
        float* yrow = out_p + (size_t)m * DM;
#pragma unroll
        for (int j = 0; j < 4; ++j) { const int c = 8 * (lane + 64 * j);
            const v4u uv = *(const GAS v4u*)(UO + (size_t)m * DM + c);
            const f32x4 x0 = *(const GAS f32x4*)(xrow + c), x1 = *(const GAS f32x4*)(xrow + c + 4), g0 = *(const GAS f32x4*)(npost_ + c), g1 = *(const GAS f32x4*)(npost_ + c + 4);
            f32x4 y0, y1;
            y0[0] = x0[0] + bflo(uv.x) * rstd * g0[0]; y0[1] = x0[1] + bfhi(uv.x) * rstd * g0[1]; y0[2] = x0[2] + bflo(uv.y) * rstd * g0[2]; y0[3] = x0[3] + bfhi(uv.y) * rstd * g0[3];
            y1[0] = x1[0] + bflo(uv.z) * rstd * g1[0]; y1[1] = x1[1] + bfhi(uv.z) * rstd * g1[1]; y1[2] = x1[2] + bflo(uv.w) * rstd * g1[2]; y1[3] = x1[3] + bfhi(uv.w) * rstd * g1[3];
            *(GAS f32x4*)(yrow + c) = y0; *(GAS f32x4*)(yrow + c + 4) = y1; }
    }
}

constexpr int N_PHASES = 9;
__global__ void __launch_bounds__(NWAVES * 64, 2) mk_fwd(Args args) {
    extern __shared__ __attribute__((aligned(16))) unsigned char lds[];
    Frame F;
    F.lds = (LAS unsigned char*)lds;
    F.tid = threadIdx.x; F.lane = F.tid & 63; F.wave = __builtin_amdgcn_readfirstlane(F.tid >> 6);
    F.G = gridDim.x; { const int bx = blockIdx.x; F.vcu = (F.G % 8 == 0) ? (bx % 8) * (F.G / 8) + bx / 8 : bx; }
    volatile LAS unsigned* MISC = (volatile LAS unsigned*)(F.lds + MISC_OFF);
    if (F.tid < 64) MISC[F.tid] = 0u;
    __syncthreads();
    gu32* ctl = (gu32*)(args.ws + WS_CTL);
    XcdBarrier bar; bar.bar = (unsigned*)(ctl + CW_BAR) + args.li * XCD_BAR_WORDS; bar.x = 0; bar.st = nullptr;
    const int lo = args.ph_lo, hi = args.ph_hi;
    if (hi - lo > 1) bar = xcd_barrier_post((unsigned*)(ctl + CW_BAR) + args.li * XCD_BAR_WORDS, MISC + 8);
#define IN(k) (lo <= (k) && (k) < hi)
#define SEAM(k) do { if (IN(k) && IN((k) + 1)) xcd_barrier(bar, F.wave); F.lane = lane_id_v(); F.tid = F.wave * 64 + F.lane; } while (0)
    using namespace pg8;
#if REPEAT_PHASE == 0
    if (IN(0) && ((PH_MASK >> 0) & 1)) { p0_prologue(F); }
#endif
    if (IN(0) && ((PH_MASK >> 0) & 1)) { p0_prologue(F); } SEAM(0);
#if REPEAT_PHASE == 1
    if (IN(1) && ((PH_MASK >> 1) & 1)) {
        Gemm g{(const bf16_t*)kargs()->out, (const bf16_t*)(kargs()->ws + WS_W1T), M, DIN, DM}; Order1 S; S.init(M, DIN, F.G, (int)blockIdx.x);
        Epi1 E{1};
        gemm_phase<Epi1, Order1, true, false>(F.lds, g, S, E, F.wave);
    }
#endif
    if (IN(1) && ((PH_MASK >> 1) & 1)) {
        Gemm g{(const bf16_t*)kargs()->out, (const bf16_t*)(kargs()->ws + WS_W1T), M, DIN, DM}; Order1 S; S.init(M, DIN, F.G, (int)blockIdx.x);
        Epi1 E{0};
        gemm_phase<Epi1, Order1, true, false>(F.lds, g, S, E, F.wave);
    } SEAM(1);
#if REPEAT_PHASE == 2
    if (IN(2) && ((PH_MASK >> 2) & 1)) { attn_phase<false>(F, true); }
#endif
    if (IN(2) && ((PH_MASK >> 2) & 1)) { attn_phase<true>(F); __syncthreads(); attn2_phase(F); } SEAM(2);
#if REPEAT_PHASE == 3
    if (IN(3) && ((PH_MASK >> 3) & 1)) { hgrn_mfma_phase<0>(F); }
#endif
    if (IN(3) && ((PH_MASK >> 3) & 1)) { hgrn_mfma_phase<0>(F); } SEAM(3);
#if REPEAT_PHASE == 4
    if (IN(4) && ((PH_MASK >> 4) & 1)) { scan_phase(F); }
#endif
    if (IN(4) && ((PH_MASK >> 4) & 1)) { scan_phase(F); } SEAM(4);
#if REPEAT_PHASE == 5
    if (IN(5) && ((PH_MASK >> 5) & 1)) { hgrn_mfma_phase<1>(F); }
#endif
    if (IN(5) && ((PH_MASK >> 5) & 1)) { hgrn_mfma_phase<1>(F); } SEAM(5);
#if REPEAT_PHASE == 6
    if (IN(6) && ((PH_MASK >> 6) & 1)) {
        Gemm g{(const bf16_t*)(kargs()->ws + WS_OAB), (const bf16_t*)(kargs()->ws + WS_W2T), M, DM, DM}; StaticOrder S; S.init(M, DM, F.G, (int)blockIdx.x);
        Epi2 E{};
        gemm_phase<Epi2, StaticOrder, true, true>(F.lds, g, S, E, F.wave);
    }
#endif
    if (IN(6) && ((PH_MASK >> 6) & 1)) {
        Gemm g{(const bf16_t*)(kargs()->ws + WS_OAB), (const bf16_t*)(kargs()->ws + WS_W2T), M, DM, DM}; StaticOrder S; S.init(M, DM, F.G, (int)blockIdx.x);
        Epi2 E{};
        gemm_phase<Epi2, StaticOrder, true, true>(F.lds, g, S, E, F.wave);
    } SEAM(6);
#if REPEAT_PHASE == 7
    if (IN(7) && ((PH_MASK >> 7) & 1)) {
        Gemm g{(const bf16_t*)(kargs()->ws + WS_MG), (const bf16_t*)(kargs()->ws + WS_W3T), M, DM, DM}; StaticOrder S; S.init(M, DM, F.G, (int)blockIdx.x);
        Epi3 E{};
        gemm_phase<Epi3, StaticOrder, true, true>(F.lds, g, S, E, F.wave);
    }
#endif
    if (IN(7) && ((PH_MASK >> 7) & 1)) {
        Gemm g{(const bf16_t*)(kargs()->ws + WS_MG), (const bf16_t*)(kargs()->ws + WS_W3T), M, DM, DM}; StaticOrder S; S.init(M, DM, F.G, (int)blockIdx.x);
        Epi3 E{};
        gemm_phase<Epi3, StaticOrder, true, true>(F.lds, g, S, E, F.wave);
    } SEAM(7);
#if REPEAT_PHASE == 8
    if (IN(8) && ((PH_MASK >> 8) & 1)) { final_phase(F); }
#endif
    if (IN(8) && ((PH_MASK >> 8) & 1)) { final_phase(F); }
#undef IN
#undef SEAM
}

extern "C" void kernel_launch(void* const* d_in, const int* in_sizes, int n_in, void* d_out, int out_size, void* d_ws, size_t ws_size, hipStream_t stream) {
    static int grid = 0;
    if (grid == 0) {
        if (n_in != 14 || out_size != (int)O_END || ws_size < WS_END) { fprintf(stderr, "kernel_launch: unexpected shapes: n_in %d out %d ws %zu\n", n_in, out_size, ws_size); grid = -1; return; }
        int dev = 0, cus = 0, per_cu = 0;
        if (hipGetDevice(&dev) != hipSuccess || hipDeviceGetAttribute(&cus, hipDeviceAttributeMultiprocessorCount, dev) != hipSuccess) { grid = -1; return; }
        if (hipFuncSetAttribute((const void*)mk_fwd, hipFuncAttributeMaxDynamicSharedMemorySize, LDS_BYTES) != hipSuccess) { fprintf(stderr, "kernel_launch: hipFuncSetAttribute failed\n"); grid = -1; return; }
        if (hipOccupancyMaxActiveBlocksPerMultiprocessor(&per_cu, (const void*)mk_fwd, NWAVES * 64, LDS_BYTES) != hipSuccess || per_cu < 1)
            fprintf(stderr, "kernel_launch: note: occupancy query reports %d workgroups per CU\n", per_cu);
        (void)hipGetLastError();
        grid = cus;
    }
    if (grid < 0) return;
    if (hipMemsetAsync((char*)d_ws + WS_CTL, 0, CTL_ZERO_BYTES, stream) != hipSuccess) return;
    Args a{};
    for (int i = 0; i < 14; ++i) a.in[i] = (const float*)d_in[i];
    a.out = (float*)d_out; a.ws = (unsigned char*)d_ws;
    constexpr int NL = MK_N_LAUNCHES;
#ifndef PROBE_LAST
#define PROBE_LAST 8
#endif
    for (int li = 0; li < NL && li <= PROBE_LAST; ++li) {
        a.ph_lo = (NL == N_PHASES) ? li : (li * N_PHASES) / NL; a.ph_hi = (NL == N_PHASES) ? li + 1 : ((li + 1) * N_PHASES) / NL; a.li = li;
        hipLaunchKernelGGL(mk_fwd, dim3(grid), dim3(NWAVES * 64), LDS_BYTES, stream, a);
    }
#ifdef PROBE_COPY
    hipMemcpyAsync(d_out, (char*)d_ws + PROBE_COPY, (size_t)132 * MiB, hipMemcpyDeviceToDevice, stream);
#endif
}
```

```cpp
#include <hip/hip_runtime.h>
#include <cstdio>
#include <cstdint>

#ifndef REPEAT_PHASE
#define REPEAT_PHASE -1
#endif
#ifndef PH_MASK
#define PH_MASK 0x1ff
#endif
#ifndef MK_N_LAUNCHES
#define MK_N_LAUNCHES 1
#endif

constexpr int DM = 2048, NBATCH = 8, SEQ = 4096, DBATCH = 16, DSEQ = 64;
constexpr int MP = NBATCH * SEQ, MS = DBATCH * DSEQ, M = MP + MS;
constexpr int DIN = 12288, DA = 1024, DB_ = 1024;
constexpr int HA = 8, DK = 128, HB = 16, DH = 64;
constexpr int NCH = M / 64;
constexpr int NUNIT = NCH * HA;
constexpr int KVROWS = 512, TS = KVROWS + DSEQ;
constexpr float EPS = 1e-6f;
constexpr float LOG2E = 1.4426950408889634f;
constexpr float QSCALE = 0.125f * LOG2E;
constexpr size_t O_YP = 0, O_YS = 67108864, O_SP = 69206016, O_KP = 70254592, O_VP = 74448896, O_SS = 78643200, O_KS = 80740352, O_VS = 81788928, O_END = 82837504;

constexpr size_t MiB = 1u << 20;
constexpr size_t WS_CTL = 0, CTL_ZERO_BYTES = 1 * MiB;
constexpr size_t WS_W2T = 49 * MiB, WS_W3T = 57 * MiB, WS_SQ = 65 * MiB, WS_DD = 70 * MiB;
constexpr size_t WS_OAB = 73 * MiB;
constexpr size_t WS_LF = 205 * MiB;
constexpr size_t WS_VA = 271 * MiB;
constexpr size_t WS_GA = 337 * MiB;
constexpr size_t WS_GB = 403 * MiB;
constexpr size_t WS_KB = 469 * MiB;
constexpr size_t WS_VB = 551 * MiB;
constexpr size_t WS_SA = 633 * MiB;
constexpr size_t WS_SB = 765 * MiB;
constexpr size_t WS_W1T = 1 * MiB;
constexpr size_t WS_ST = 469 * MiB;
constexpr size_t WS_MG = 205 * MiB;
constexpr size_t WS_UO = 469 * MiB;
constexpr size_t WS_END = 897 * MiB;
constexpr size_t KB_S = (size_t)NBATCH * HB * SEQ * DH;

constexpr int CW_TMO = 0, CW_CODE = 1, CW_BAR = 4096;

constexpr int LDS_BYTES = 163840;
constexpr int MISC_OFF = LDS_BYTES - 256;
constexpr int NWAVES = 8;

#define GAS __attribute__((address_space(1)))
#define LAS __attribute__((address_space(3)))
typedef unsigned short bf16;
typedef unsigned v4u __attribute__((ext_vector_type(4)));
typedef unsigned v2u __attribute__((ext_vector_type(2)));
typedef float f32x4 __attribute__((ext_vector_type(4)));
typedef float f32x16 __attribute__((ext_vector_type(16)));
typedef short bf16x8 __attribute__((ext_vector_type(8)));
typedef GAS unsigned gu32;
#define RLX_AGENT __ATOMIC_RELAXED, __HIP_MEMORY_SCOPE_AGENT
#define LDS_WAIT() asm volatile("s_waitcnt lgkmcnt(0)" ::: "memory")
#define VM_WAIT() asm volatile("s_waitcnt vmcnt(0)" ::: "memory")
__device__ __forceinline__ unsigned f2bf(float f) { unsigned u = __builtin_bit_cast(unsigned, f); return (u + 0x7fffu + ((u >> 16) & 1u)) >> 16; }
typedef float f32x2_g __attribute__((ext_vector_type(2))); typedef __bf16 bf16x2_g __attribute__((ext_vector_type(2)));
__device__ __forceinline__ unsigned pk2(float lo, float hi) { const f32x2_g v = {lo, hi}; const bf16x2_g b = __builtin_convertvector(v, bf16x2_g); return __builtin_bit_cast(unsigned, b); }
__device__ __forceinline__ float bflo(unsigned w) { return __builtin_bit_cast(float, w << 16); }
__device__ __forceinline__ float bfhi(unsigned w) { return __builtin_bit_cast(float, w & 0xffff0000u); }
__device__ __forceinline__ float bf2f(bf16 h) { return __builtin_bit_cast(float, (unsigned)h << 16); }
__device__ __forceinline__ unsigned pkh2(float lo, float hi) { const _Float16 a = (_Float16)lo, b = (_Float16)hi; return (unsigned)__builtin_bit_cast(unsigned short, a) | ((unsigned)__builtin_bit_cast(unsigned short, b) << 16); }
__device__ __forceinline__ float h2f(unsigned short h) { return (float)__builtin_bit_cast(_Float16, h); }
__device__ __forceinline__ float fast_sigmoid(float z) { return __builtin_amdgcn_rcpf(1.0f + __expf(-z)); }
__device__ __forceinline__ float fast_silu(float z) { return z * fast_sigmoid(z); }

struct Args { const float* in[14]; float* out; unsigned char* ws; int ph_lo, ph_hi, li, pad; };
typedef const __attribute__((address_space(4))) Args* KArgs;
__device__ __forceinline__ KArgs kargs() { KArgs p = (KArgs)__builtin_amdgcn_kernarg_segment_ptr(); asm volatile("" : "+s"(p)); return p; }
#define KIN(i) (kargs()->in[i])

namespace pg8 {
#define PG8_LAS __attribute__((address_space(3)))
typedef unsigned short bf16_t;
typedef short bf16x8 __attribute__((ext_vector_type(8)));
typedef float f32x4 __attribute__((ext_vector_type(4)));
typedef unsigned u32x4 __attribute__((ext_vector_type(4)));
constexpr int BM = 256, BK = 64, HALF = 128, HTB = HALF * BK * 2  , STAGE_BYTES = 8 * HTB, NXCD = 8, WGM = 8;

__host__ __device__ __forceinline__ int lds_byte(int r, int c) { const int st = (r >> 4) * 2 + (c >> 5), rr = r & 15, cc = c & 31, ob = rr * 64 + cc * 2; return st * 1024 + (ob ^ (((ob >> 9) & 1) << 5)); }
__host__ __device__ __forceinline__ void stage_rc(int b, int& R, int& C) { const int st = b / 1024, sb = b % 1024, swz = sb ^ (((sb >> 9) & 1) << 5); R = (st >> 1) * 16 + swz / 64; C = (st & 1) * 32 + (swz % 64) / 2; }
__host__ __device__ __forceinline__ int perm32(int rho) { const int n = rho >> 4, i = rho & 15; return 8 * (i >> 2) + 4 * n + (i & 3); }

struct Unit { int pm, pn, tr; };
struct Gemm { const bf16_t* A; const bf16_t* Bt; int M, N, K; };

struct StaticOrder {
    int nM, nN, nwg, G, c;
    __host__ __device__ void init(int M, int N, int G_, int c_) { nM = M / BM; nN = N / BM; nwg = nM * nN; G = G_; c = c_; }
    __host__ __device__ bool next(int i, Unit& u) const {
        const long L = (long)i * G + c; if (L >= nwg) return false;
        int wgid = (int)L; { const int q = nwg / NXCD, r = nwg % NXCD, xcd = wgid % NXCD, off = wgid / NXCD; wgid = (xcd < r ? xcd * (q + 1) : r * (q + 1) + (xcd - r) * q) + off; }
        const int nig = WGM * nN, gid = wgid / nig, fm = gid * WGM, gsz = (nM - fm) < WGM ? (nM - fm) : WGM;
        u.pm = fm + ((wgid % nig) % gsz); u.pn = (wgid % nig) / gsz; u.tr = 0; return true;
    }
    __device__ __forceinline__ void a_ready(const Unit&) const {}
    __device__ __forceinline__ void done(const Unit&) const {}
};
struct Order1 : StaticOrder {
    __host__ __device__ bool next(int i, Unit& u) const { if (!StaticOrder::next(i, u)) return false; const int ty = u.pn >> 2; u.tr = (ty == 2 || ty == 6) ? 1 : 0; return true; }
};

typedef float f32x2_t __attribute__((ext_vector_type(2))); typedef __bf16 bf16x2_t __attribute__((ext_vector_type(2)));
__device__ __forceinline__ unsigned cvt_pk_bf16(float lo, float hi) { const f32x2_t v = {lo, hi}; const bf16x2_t b = __builtin_convertvector(v, bf16x2_t); return __builtin_bit_cast(unsigned, b); }
#define EPI_FOR_ALL _Pragma("unroll") for (int ai = 0; ai < 2; ++ai) _Pragma("unroll") for (int m = 0; m < 4; ++m) _Pragma("unroll") for (int bj = 0; bj < 2; ++bj)
struct Epi1 {
    static constexpr bool PERM = true, AFTER_DRAIN = false, MIDHOOK = false;
    int dummy;
    __device__ __forceinline__ void operator()(const f32x4 (&acc)[2][2][4][2], const Unit& u, int wr, int wc, int fr, int fq) const {
        { int l_; asm volatile("v_mbcnt_lo_u32_b32 %0, -1, 0\n\tv_mbcnt_hi_u32_b32 %0, -1, %0" : "=v"(l_)); fr = l_ & 15; fq = l_ >> 4; } asm volatile("" : "+s"(wr), "+s"(wc));
        KArgs ka_ = kargs(); unsigned char* const ws = ka_->ws; float* const out = ka_->out; const float* const lbl = ka_->in[7];
        bf16_t* const OAB = (bf16_t*)(ws + WS_OAB); bf16_t* const LF = (bf16_t*)(ws + WS_LF); bf16_t* const VA = (bf16_t*)(ws + WS_VA); bf16_t* const GA = (bf16_t*)(ws + WS_GA); bf16_t* const GB = (bf16_t*)(ws + WS_GB);
        bf16_t* const KB = (bf16_t*)(ws + WS_KB); bf16_t* const VB = (bf16_t*)(ws + WS_VB); bf16_t* const SA = (bf16_t*)(ws + WS_SA); bf16_t* const SB = (bf16_t*)(ws + WS_SB);
        int ty = u.pn < 32 ? (u.pn >> 2) : (u.pn < 40 ? 8 : 9);
#ifdef TY_ONLY
        ty = TY_ONLY;
#endif
        const int rbase = (u.tr ? u.pn : u.pm) * BM + wr * 64 + fr;
        const int cbase = (u.tr ? u.pm : u.pn) * BM + wc * 32 + 8 * fq;
        if (dummy) {
            bf16_t* const DUM = (bf16_t*)(ws + 897 * MiB);
            EPI_FOR_ALL { const int r = rbase + ai * 128 + m * 16, c = cbase + bj * 128; const f32x4 v0 = acc[ai][bj][m][0], v1 = acc[ai][bj][m][1];
                u32x4 w; w.x = cvt_pk_bf16(v0[0], v0[1]); w.y = cvt_pk_bf16(v0[2], v0[3]); w.z = cvt_pk_bf16(v1[0], v1[1]); w.w = cvt_pk_bf16(v1[2], v1[3]);
                *(u32x4*)(DUM + (unsigned)((r & 16383) * 2048 + (c & 2047))) = w; }
        } else if (ty == 0) {
            EPI_FOR_ALL { const int r = rbase + ai * 128 + m * 16, c = cbase + bj * 128; const f32x4 v0 = acc[ai][bj][m][0], v1 = acc[ai][bj][m][1];
                u32x4 w; w.x = cvt_pk_bf16(fast_silu(v0[0]), fast_silu(v0[1])); w.y = cvt_pk_bf16(fast_silu(v0[2]), fast_silu(v0[3])); w.z = cvt_pk_bf16(fast_silu(v1[0]), fast_silu(v1[1])); w.w = cvt_pk_bf16(fast_silu(v1[2]), fast_silu(v1[3]));
                *(u32x4*)(OAB + (unsigned)(r * 2048 + c)) = w; }
        } else if (ty == 1) {
            float oml[2][8];
#pragma unroll
            for (int bj = 0; bj < 2; ++bj) { const int cc = cbase + bj * 128 - 1024;
#pragma unroll
                for (int e = 0; e < 8; ++e) { const float l0 = lbl[cc + e], l1 = lbl[1024 + cc + e]; const float lb = __builtin_amdgcn_rcpf(1.0f + __expf(l1 - l0)); oml[bj][e] = 1.0f - lb; } }
            EPI_FOR_ALL { const int r = rbase + ai * 128 + m * 16, cc = cbase + bj * 128 - 1024; const f32x4 v0 = acc[ai][bj][m][0], v1 = acc[ai][bj][m][1];
                float lf[8];
#pragma unroll
                for (int e = 0; e < 8; ++e) { const float z = e < 4 ? v0[e & 3] : v1[e & 3]; const float kq = oml[bj][e] * __builtin_amdgcn_rcpf(1.0f + __expf(z)); const float ser = -kq * (1.0f + kq * (0.5f + kq * (0.33333334f + kq * (0.25f + kq * 0.2f)))); lf[e] = kq < 0.0625f ? ser : __logf(1.0f - kq); }
                u32x4 w; w.x = pkh2(lf[0], lf[1]); w.y = pkh2(lf[2], lf[3]); w.z = pkh2(lf[4], lf[5]); w.w = pkh2(lf[6], lf[7]);
                const int gc = r >> 6, t = r & 63, h = cc >> 7, kk = cc & 127;
                *(u32x4*)(LF + (unsigned)(((gc * 8 + h) * 64 + t) * 128 + kk)) = w; }
        } else if (ty == 2) {
            EPI_FOR_ALL { const int cc = rbase + ai * 128 + m * 16 - 2048, tg = cbase + bj * 128; const f32x4 v0 = acc[ai][bj][m][0], v1 = acc[ai][bj][m][1];
                u32x4 w; w.x = cvt_pk_bf16(v0[0], v0[1]); w.y = cvt_pk_bf16(v0[2], v0[3]); w.z = cvt_pk_bf16(v1[0], v1[1]); w.w = cvt_pk_bf16(v1[2], v1[3]);
                const int gc = tg >> 6, t0 = tg & 63, h = cc >> 7, dv = cc & 127;
                *(u32x4*)(VA + (unsigned)(((gc * 8 + h) * 128 + dv) * 64 + t0)) = w; }
        } else if (ty == 3) {
            EPI_FOR_ALL { const int r = rbase + ai * 128 + m * 16, cc = cbase + bj * 128 - 3072; const f32x4 v0 = acc[ai][bj][m][0], v1 = acc[ai][bj][m][1];
                u32x4 w; w.x = cvt_pk_bf16(fast_silu(v0[0]), fast_silu(v0[1])); w.y = cvt_pk_bf16(fast_silu(v0[2]), fast_silu(v0[3])); w.z = cvt_pk_bf16(fast_silu(v1[0]), fast_silu(v1[1])); w.w = cvt_pk_bf16(fast_silu(v1[2]), fast_silu(v1[3]));
                const int gc = r >> 6, t = r & 63, h = cc >> 7, kk = cc & 127;
                *(u32x4*)(GA + (unsigned)(((gc * 8 + h) * 64 + t) * 128 + kk)) = w; }
        } else if (ty == 4) {
            EPI_FOR_ALL { const int r = rbase + ai * 128 + m * 16, cc = cbase + bj * 128 - 4096; const f32x4 v0 = acc[ai][bj][m][0] * QSCALE, v1 = acc[ai][bj][m][1] * QSCALE;
                u32x4 w; w.x = cvt_pk_bf16(v0[0], v0[1]); w.y = cvt_pk_bf16(v0[2], v0[3]); w.z = cvt_pk_bf16(v1[0], v1[1]); w.w = cvt_pk_bf16(v1[2], v1[3]);
                *(u32x4*)(OAB + (unsigned)(r * 2048 + 1024 + cc)) = w; }
        } else if (ty == 5) {
            EPI_FOR_ALL { const int r = rbase + ai * 128 + m * 16, cc = cbase + bj * 128 - 5120; const f32x4 v0 = acc[ai][bj][m][0], v1 = acc[ai][bj][m][1];
                u32x4 w; w.x = cvt_pk_bf16(v0[0], v0[1]); w.y = cvt_pk_bf16(v0[2], v0[3]); w.z = cvt_pk_bf16(v1[0], v1[1]); w.w = cvt_pk_bf16(v1[2], v1[3]);
                const int h = cc >> 6, d = cc & 63;
                if (r < MP) { const int b = r >> 12, t = r & 4095;
                    *(u32x4*)(KB + (unsigned)(((b * 16 + h) * SEQ + t) * 64 + d)) = w;
                    if (t >= SEQ - KVROWS) { float* o = out + O_KP + (unsigned)((b * KVROWS + t - (SEQ - KVROWS)) * 1024 + cc); *(f32x4*)o = v0; *(f32x4*)(o + 4) = v1; }
                } else { const int rs = r - MP, sb = rs >> 6, t = rs & 63;
                    *(u32x4*)(KB + (unsigned)((int)KB_S + ((sb * 16 + h) * TS + KVROWS + t) * 64 + d)) = w;
                    float* o = out + (unsigned)((int)O_KS + rs * 1024 + cc); *(f32x4*)o = v0; *(f32x4*)(o + 4) = v1; } }
        } else if (ty == 6) {
            EPI_FOR_ALL { const int cc = rbase + ai * 128 + m * 16 - 6144, tg = cbase + bj * 128; const f32x4 v0 = acc[ai][bj][m][0], v1 = acc[ai][bj][m][1];
                u32x4 w; w.x = cvt_pk_bf16(v0[0], v0[1]); w.y = cvt_pk_bf16(v0[2], v0[3]); w.z = cvt_pk_bf16(v1[0], v1[1]); w.w = cvt_pk_bf16(v1[2], v1[3]);
                const int h = cc >> 6, d = cc & 63;
                if (tg < MP) { const int b = tg >> 12, t0 = tg & 4095;
                    *(u32x4*)(VB + (unsigned)(((b * 16 + h) * 64 + d) * SEQ + t0)) = w;
                    if (t0 >= SEQ - KVROWS) { float* o = out + O_VP + (unsigned)((b * KVROWS + t0 - (SEQ - KVROWS)) * 1024 + cc);
#pragma unroll
                        for (int e = 0; e < 8; ++e) o[e * 1024] = e < 4 ? v0[e & 3] : v1[e & 3]; }
                } else { const int rs = tg - MP, sb = rs >> 6, t0 = rs & 63;
                    *(u32x4*)(VB + (unsigned)((int)KB_S + ((sb * 16 + h) * 64 + d) * TS + KVROWS + t0)) = w;
                    float* o = out + (unsigned)((int)O_VS + rs * 1024 + cc);
#pragma unroll
                    for (int e = 0; e < 8; ++e) o[e * 1024] = e < 4 ? v0[e & 3] : v1[e & 3]; } }
        } else if (ty == 7) {
            EPI_FOR_ALL { const int r = rbase + ai * 128 + m * 16, cc = cbase + bj * 128 - 7168; const f32x4 v0 = acc[ai][bj][m][0], v1 = acc[ai][bj][m][1];
                u32x4 w; w.x = cvt_pk_bf16(fast_silu(v0[0]), fast_silu(v0[1])); w.y = cvt_pk_bf16(fast_silu(v0[2]), fast_silu(v0[3])); w.z = cvt_pk_bf16(fast_silu(v1[0]), fast_silu(v1[1])); w.w = cvt_pk_bf16(fast_silu(v1[2]), fast_silu(v1[3]));
                *(u32x4*)(GB + (unsigned)(r * 1024 + cc)) = w; }
        } else {
            bf16_t* dst = ty == 8 ? SA : SB; const int coff = ty == 8 ? 8192 : 10240;
            EPI_FOR_ALL { const int r = rbase + ai * 128 + m * 16, cc = cbase + bj * 128 - coff; const f32x4 v0 = acc[ai][bj][m][0], v1 = acc[ai][bj][m][1];
                u32x4 w; w.x = cvt_pk_bf16(fast_sigmoid(v0[0]), fast_sigmoid(v0[1])); w.y = cvt_pk_bf16(fast_sigmoid(v0[2]), fast_sigmoid(v0[3])); w.z = cvt_pk_bf16(fast_sigmoid(v1[0]), fast_sigmoid(v1[1])); w.w = cvt_pk_bf16(fast_sigmoid(v1[2]), fast_sigmoid(v1[3]));
                *(u32x4*)(dst + (unsigned)(r * 2048 + cc)) = w; }
        }
    }
};
struct Epi2 {
    static constexpr bool PERM = true, AFTER_DRAIN = false, MIDHOOK = true;
    __device__ __forceinline__ void mid(f32x4 (&acc)[2][2][4][2], const Unit& u, int wr, int wc, int fr, int fq) const {
        unsigned char* const ws_ = kargs()->ws; const bf16_t* const SA = (const bf16_t*)(ws_ + WS_SA); const bf16_t* const SB = (const bf16_t*)(ws_ + WS_SB);
        { int l_; asm volatile("v_mbcnt_lo_u32_b32 %0, -1, 0\n\tv_mbcnt_hi_u32_b32 %0, -1, %0" : "=v"(l_)); fr = l_ & 15; fq = l_ >> 4; } asm volatile("" : "+s"(wr), "+s"(wc));
        const int rbase = u.pm * BM + wr * 64 + fr, cbase = u.pn * BM + wc * 32 + 8 * fq;
        EPI_FOR_ALL { const unsigned off = (unsigned)((rbase + ai * 128 + m * 16) * 2048 + cbase + bj * 128);
            const u32x4 a = *(const u32x4*)(SA + off), b = *(const u32x4*)(SB + off);
            f32x4 r0, r1;
            r0[0] = bflo(a.x) * __builtin_amdgcn_rcpf(bflo(b.x)); r0[1] = bfhi(a.x) * __builtin_amdgcn_rcpf(bfhi(b.x)); r0[2] = bflo(a.y) * __builtin_amdgcn_rcpf(bflo(b.y)); r0[3] = bfhi(a.y) * __builtin_amdgcn_rcpf(bfhi(b.y));
            r1[0] = bflo(a.z) * __builtin_amdgcn_rcpf(bflo(b.z)); r1[1] = bfhi(a.z) * __builtin_amdgcn_rcpf(bfhi(b.z)); r1[2] = bflo(a.w) * __builtin_amdgcn_rcpf(bflo(b.w)); r1[3] = bfhi(a.w) * __builtin_amdgcn_rcpf(bfhi(b.w));
            acc[ai][bj][m][0] *= r0; acc[ai][bj][m][1] *= r1; if (bj == 1 && (m & 1)) asm volatile("" ::: "memory"); }
    }
    __device__ __forceinline__ void operator()(const f32x4 (&acc)[2][2][4][2], const Unit& u, int wr, int wc, int fr, int fq) const {
        { int l_; asm volatile("v_mbcnt_lo_u32_b32 %0, -1, 0\n\tv_mbcnt_hi_u32_b32 %0, -1, %0" : "=v"(l_)); fr = l_ & 15; fq = l_ >> 4; } asm volatile("" : "+s"(wr), "+s"(wc));
        unsigned char* const ws_ = kargs()->ws; const bf16_t* const SB = (const bf16_t*)(ws_ + WS_SB); bf16_t* const MG = (bf16_t*)(ws_ + WS_MG);
        const int rbase = u.pm * BM + wr * 64 + fr, cbase = u.pn * BM + wc * 32 + 8 * fq;
        EPI_FOR_ALL { const unsigned off = (unsigned)((rbase + ai * 128 + m * 16) * 2048 + cbase + bj * 128);
            const u32x4 b = *(const u32x4*)(SB + off); const f32x4 v0 = acc[ai][bj][m][0], v1 = acc[ai][bj][m][1];
            u32x4 w; w.x = cvt_pk_bf16(v0[0] * bflo(b.x), v0[1] * bfhi(b.x)); w.y = cvt_pk_bf16(v0[2] * bflo(b.y), v0[3] * bfhi(b.y)); w.z = cvt_pk_bf16(v1[0] * bflo(b.z), v1[1] * bfhi(b.z)); w.w = cvt_pk_bf16(v1[2] * bflo(b.w), v1[3] * bfhi(b.w));
            *(u32x4*)(MG + off) = w; if (bj == 1 && (m & 1)) asm volatile("" ::: "memory"); }
    }
};
struct Epi3 {
    static constexpr bool PERM = true, AFTER_DRAIN = false, MIDHOOK = false;
    __device__ __forceinline__ void operator()(const f32x4 (&acc)[2][2][4][2], const Unit& u, int wr, int wc, int fr, int fq) const {
        { int l_; asm volatile("v_mbcnt_lo_u32_b32 %0, -1, 0\n\tv_mbcnt_hi_u32_b32 %0, -1, %0" : "=v"(l_)); fr = l_ & 15; fq = l_ >> 4; } asm volatile("" : "+s"(wr), "+s"(wc));
        unsigned char* const ws_ = kargs()->ws; bf16_t* const UO = (bf16_t*)(ws_ + WS_UO); float* const SQ = (float*)(ws_ + WS_SQ);
        const int rbase = u.pm * BM + wr * 64 + fr, cbase = u.pn * BM + wc * 32 + 8 * fq;
#pragma unroll
        for (int ai = 0; ai < 2; ++ai)
#pragma unroll
            for (int m = 0; m < 4; ++m) { const int r = rbase + ai * 128 + m * 16; float s = 0.f;
#pragma unroll
                for (int bj = 0; bj < 2; ++bj) { const f32x4 v0 = acc[ai][bj][m][0], v1 = acc[ai][bj][m][1];
                    s += (v0[0] * v0[0] + v0[1] * v0[1]) + (v0[2] * v0[2] + v0[3] * v0[3]) + (v1[0] * v1[0] + v1[1] * v1[1]) + (v1[2] * v1[2] + v1[3] * v1[3]);
                    u32x4 w; w.x = cvt_pk_bf16(v0[0], v0[1]); w.y = cvt_pk_bf16(v0[2], v0[3]); w.z = cvt_pk_bf16(v1[0], v1[1]); w.w = cvt_pk_bf16(v1[2], v1[3]);
                    *(u32x4*)(UO + (unsigned)(r * 2048 + cbase + bj * 128)) = w; }
                s += __shfl_xor(s, 16); s += __shfl_xor(s, 32);
                if (fq == 0) SQ[(unsigned)(r * 32 + u.pn * 4 + wc)] = s; }
    }
};
#undef EPI_FOR_ALL

template <class Epi, class Sched, bool ALIGN_EPI = false, bool SP2 = false>
__device__ __forceinline__ void gemm_phase(PG8_LAS unsigned char* lds, const Gemm g, const Sched& S, const Epi& E, int wave_s) {
    int lane; asm volatile("v_mbcnt_lo_u32_b32 %0, -1, 0\n\tv_mbcnt_hi_u32_b32 %0, -1, %0" : "=v"(lane));
    const int wid = wave_s, tid = wid * 64 + lane, wr = wid >> 2, wc = wid & 3, fr = lane & 15, fq = lane >> 4;
    const int K = g.K, nt = K / BK;
    unsigned voffA[2], voffB[2];
#pragma unroll
    for (int i = 0; i < 2; ++i) { int R, C; stage_rc(tid * 16 + i * 8192, R, C); const int Rb = Epi::PERM ? ((R & ~31) + perm32(R & 31)) : R;
        voffA[i] = (unsigned)(R * K + C) * 2u; voffB[i] = (unsigned)(Rb * K + C) * 2u; }
    const size_t kstep = (size_t)(BK * 2);
    const size_t hstep = (size_t)HALF * K * 2;
    const size_t tstep = 2 * hstep;
    const unsigned ldsw = (unsigned)wid * 1024u;
    const int aoff = lds_byte(wr * 64 + fr, fq * 8), boff = lds_byte(wc * 32 + fr, fq * 8);
#define PG8_SA(b, h) (((b) * 2 + (h)) * HTB)
#define PG8_SB(b, h) ((4 + (b) * 2 + (h)) * HTB)
#define PG8_STAGE(bufoff, gbase, voff) do { _Pragma("unroll") for (int _i = 0; _i < 2; ++_i) \
        __builtin_amdgcn_global_load_lds((const unsigned*)((const char*)(gbase) + (voff)[_i]), (PG8_LAS unsigned*)(lds + (bufoff) + ldsw + _i * 8192), 16, 0, 0); } while (0)
#define PG8_LDA(dst, b, h) do { _Pragma("unroll") for (int m = 0; m < 4; ++m) _Pragma("unroll") for (int k = 0; k < 2; ++k) dst[m][k] = *(const PG8_LAS bf16x8*)(lds + PG8_SA(b, h) + aoff + m * 2048 + k * 1024); } while (0)
#define PG8_LDB(dst, b, h) do { _Pragma("unroll") for (int n = 0; n < 2; ++n) _Pragma("unroll") for (int k = 0; k < 2; ++k) dst[n][k] = *(const PG8_LAS bf16x8*)(lds + PG8_SB(b, h) + boff + n * 2048 + k * 1024); } while (0)
#define PG8_MMA(ai, bj, At, Bt) do { __builtin_amdgcn_s_setprio(1); _Pragma("unroll") for (int m = 0; m < 4; ++m) _Pragma("unroll") for (int n = 0; n < 2; ++n) _Pragma("unroll") for (int k = 0; k < 2; ++k) \
        acc[ai][bj][m][n] = __builtin_amdgcn_mfma_f32_16x16x32_bf16(Bt[n][k], At[m][k], acc[ai][bj][m][n], 0, 0, 0); __builtin_amdgcn_s_setprio(0); } while (0)
#define PG8_WAIT_V(n) asm volatile("s_waitcnt vmcnt(" #n ")" ::: "memory")
#define PG8_WAIT_L(n) asm volatile("s_waitcnt lgkmcnt(" #n ")" ::: "memory")
#define PG8_BAR __builtin_amdgcn_s_barrier()
#define PG8_SCHED __builtin_amdgcn_sched_barrier(0)
    Unit cur, nxt; int ui = 0;
    if (!S.next(0, cur)) return;
    f32x4 acc[2][2][4][2];
#pragma unroll
    for (int a = 0; a < 2; ++a)
#pragma unroll
        for (int b = 0; b < 2; ++b)
#pragma unroll
            for (int m = 0; m < 4; ++m)
#pragma unroll
                for (int n = 0; n < 2; ++n) acc[a][b][m][n] = (f32x4){0.f, 0.f, 0.f, 0.f};
    bf16x8 At[4][2], B0[2][2], B1[2][2];
    const char* cA = cur.tr ? (const char*)g.Bt + (size_t)cur.pn * tstep : (const char*)g.A + (size_t)cur.pm * tstep;
    const char* cB = cur.tr ? (const char*)g.A + (size_t)cur.pm * tstep : (const char*)g.Bt + (size_t)cur.pn * tstep;
    S.a_ready(cur);
    if constexpr (SP2) {
        PG8_STAGE(PG8_SB(0, 0), cB, voffB); PG8_STAGE(PG8_SB(0, 1), cB + hstep, voffB); PG8_STAGE(PG8_SA(0, 0), cA, voffA); PG8_STAGE(PG8_SA(0, 1), cA + hstep, voffA);
        if (wr == 1) PG8_BAR;
        PG8_WAIT_V(2); PG8_BAR;
        PG8_STAGE(PG8_SB(1, 0), cB + kstep, voffB); PG8_STAGE(PG8_SA(1, 0), cA + kstep, voffA); PG8_STAGE(PG8_SB(1, 1), cB + hstep + kstep, voffB);
        PG8_WAIT_V(6); PG8_BAR;
    } else {
        PG8_STAGE(PG8_SB(0, 0), cB, voffB); PG8_STAGE(PG8_SA(0, 0), cA, voffA); PG8_STAGE(PG8_SB(0, 1), cB + hstep, voffB); PG8_STAGE(PG8_SA(0, 1), cA + hstep, voffA);
        if (wr == 1) PG8_BAR;
        PG8_WAIT_V(4); PG8_BAR;
        PG8_STAGE(PG8_SB(1, 0), cB + kstep, voffB); PG8_STAGE(PG8_SA(1, 0), cA + kstep, voffA); PG8_STAGE(PG8_SB(1, 1), cB + hstep + kstep, voffB);
        PG8_WAIT_V(6); PG8_BAR;
    }
    for (;;) {
        const bool has_next = S.next(ui + 1, nxt);
        const char* nA = has_next ? (nxt.tr ? (const char*)g.Bt + (size_t)nxt.pn * tstep : (const char*)g.A + (size_t)nxt.pm * tstep) : cA;
        const char* nB = has_next ? (nxt.tr ? (const char*)g.A + (size_t)nxt.pm * tstep : (const char*)g.Bt + (size_t)nxt.pn * tstep) : cB;
        for (int t = 0; t < nt; t += 2) {
            if constexpr (Epi::MIDHOOK) { if (t == (nt >> 1)) E.mid(acc, cur, wr, wc, fr, fq); }
            const bool last = (t == nt - 2);
            const char* a1 = cA + (size_t)(t + 1) * kstep;
            const char* a2 = last ? nA : cA + (size_t)(t + 2) * kstep; const char* b2 = last ? nB : cB + (size_t)(t + 2) * kstep;
            const char* a3 = a2 + kstep; const char* b3 = b2 + kstep;
            if (last && has_next) S.a_ready(nxt);
            if constexpr (SP2) {
            PG8_LDB(B0, 0, 0); PG8_LDB(B1, 0, 1); PG8_SCHED; PG8_LDA(At, 0, 0); PG8_STAGE(PG8_SA(1, 1), a1 + hstep, voffA);
            PG8_WAIT_V(8); PG8_WAIT_L(0); PG8_BAR; PG8_MMA(0, 0, At, B0); PG8_MMA(0, 1, At, B1); PG8_BAR; PG8_SCHED;
            PG8_LDA(At, 0, 1); PG8_STAGE(PG8_SB(0, 0), b2, voffB); PG8_STAGE(PG8_SB(0, 1), b2 + hstep, voffB); PG8_STAGE(PG8_SA(0, 0), a2, voffA);
            PG8_WAIT_V(8); PG8_WAIT_L(0); PG8_BAR; PG8_MMA(1, 0, At, B0); PG8_MMA(1, 1, At, B1); PG8_BAR; PG8_SCHED;
            PG8_LDB(B0, 1, 0); PG8_LDB(B1, 1, 1); PG8_SCHED; PG8_LDA(At, 1, 0); PG8_STAGE(PG8_SA(0, 1), a2 + hstep, voffA);
            PG8_WAIT_V(8); PG8_WAIT_L(0); PG8_BAR; PG8_MMA(0, 0, At, B0); PG8_MMA(0, 1, At, B1); PG8_BAR; PG8_SCHED;
            PG8_LDA(At, 1, 1); PG8_STAGE(PG8_SB(1, 0), b3, voffB); PG8_STAGE(PG8_SB(1, 1), b3 + hstep, voffB); PG8_STAGE(PG8_SA(1, 0), a3, voffA);
            PG8_WAIT_V(8); PG8_WAIT_L(0); PG8_BAR; PG8_MMA(1, 0, At, B0); PG8_MMA(1, 1, At, B1); PG8_BAR; PG8_SCHED;
            } else {
            PG8_LDB(B0, 0, 0); PG8_SCHED; PG8_LDA(At, 0, 0); PG8_STAGE(PG8_SA(1, 1), a1 + hstep, voffA);
            PG8_WAIT_L(8); PG8_BAR; PG8_WAIT_L(0); PG8_MMA(0, 0, At, B0); PG8_BAR; PG8_SCHED;
            PG8_LDB(B1, 0, 1); PG8_STAGE(PG8_SB(0, 0), b2, voffB);
            PG8_BAR; PG8_WAIT_L(0); PG8_MMA(0, 1, At, B1); PG8_BAR;
            PG8_LDA(At, 0, 1); PG8_STAGE(PG8_SA(0, 0), a2, voffA);
            PG8_BAR; PG8_WAIT_L(0); PG8_MMA(1, 0, At, B0); PG8_BAR; PG8_SCHED;
            PG8_STAGE(PG8_SB(0, 1), b2 + hstep, voffB);
            PG8_WAIT_V(6); PG8_BAR; PG8_MMA(1, 1, At, B1); PG8_BAR;
            PG8_LDB(B0, 1, 0); PG8_SCHED; PG8_LDA(At, 1, 0); PG8_STAGE(PG8_SA(0, 1), a2 + hstep, voffA);
            PG8_WAIT_L(8); PG8_BAR; PG8_WAIT_L(0); PG8_MMA(0, 0, At, B0); PG8_BAR; PG8_SCHED;
            PG8_LDB(B1, 1, 1); PG8_STAGE(PG8_SB(1, 0), b3, voffB);
            PG8_BAR; PG8_WAIT_L(0); PG8_MMA(0, 1, At, B1); PG8_BAR;
            PG8_LDA(At, 1, 1); PG8_STAGE(PG8_SA(1, 0), a3, voffA);
            PG8_BAR; PG8_WAIT_L(0); PG8_MMA(1, 0, At, B0); PG8_BAR; PG8_SCHED;
            PG8_STAGE(PG8_SB(1, 1), b3 + hstep, voffB);
            PG8_WAIT_V(6); PG8_BAR; PG8_MMA(1, 1, At, B1); PG8_BAR;
            }
        }
        if constexpr (ALIGN_EPI) { if (wr == 0) PG8_BAR; }
        if constexpr (!Epi::AFTER_DRAIN) { E(acc, cur, wr, wc, fr, fq); S.done(cur); }
        if (!has_next) break;
#pragma unroll
        for (int a = 0; a < 2; ++a)
#pragma unroll
            for (int b = 0; b < 2; ++b)
#pragma unroll
                for (int m = 0; m < 4; ++m)
#pragma unroll
                    for (int n = 0; n < 2; ++n) acc[a][b][m][n] = (f32x4){0.f, 0.f, 0.f, 0.f};
        cur = nxt; cA = nA; cB = nB; ++ui;
        if constexpr (ALIGN_EPI) { if (wr == 1) PG8_BAR; }
    }
    PG8_WAIT_V(0);
    if constexpr (!ALIGN_EPI) { if (wr == 0) PG8_BAR; }
    PG8_BAR;
    if constexpr (Epi::AFTER_DRAIN) { E.fused(acc, cur, wr, wc, fr, fq, lds, wid, lane); S.done(cur); }
#undef PG8_SA
#undef PG8_SB
#undef PG8_STAGE
#undef PG8_LDA
#undef PG8_LDB
#undef PG8_MMA
#undef PG8_WAIT_V
#undef PG8_WAIT_L
#undef PG8_BAR
#undef PG8_SCHED
}
}

#define XB_TMO      128
#define XB_XCNT(j)  (256  + 64 * (j))
#define XB_XSUB(j)  (1280 + 64 * (j))
#define XB_XGEN(j)  (2304 + 64 * (j))
#define XB_TOP      3328
#define XB_TOPGEN   3392
#define XCD_BAR_WORDS 3456
#define XB_SPIN_CAP (1u << 18)

__device__ __forceinline__ unsigned xb_ld(unsigned* p)              { return __hip_atomic_load(p, __ATOMIC_RELAXED, __HIP_MEMORY_SCOPE_AGENT); }
__device__ __forceinline__ unsigned xb_add(unsigned* p, unsigned v) { return __hip_atomic_fetch_add(p, v, __ATOMIC_RELAXED, __HIP_MEMORY_SCOPE_AGENT); }
__device__ __forceinline__ unsigned xb_xcc_id() { return (unsigned)__builtin_amdgcn_s_getreg((3 << 11) | 20) & 0xFu; }
#define XB_SPIN(cond, bar) do { unsigned _sp = 0; while (cond) { __builtin_amdgcn_s_sleep(1); \
    if ((++_sp & 255u) == 0u) { if (xb_ld(&(bar)[XB_TMO])) break; if (_sp > XB_SPIN_CAP) { atomicAdd(&(bar)[XB_TMO], 1u); break; } } } } while (0)

struct XcdBarrier { unsigned* bar; unsigned x; volatile LAS unsigned* st; };

__device__ __forceinline__ XcdBarrier xcd_barrier_post(unsigned* bar, volatile LAS unsigned* st) {
    XcdBarrier b; b.bar = bar; b.x = xb_xcc_id(); b.st = st;
    if (threadIdx.x == 0) (void)xb_add(&bar[XB_XCNT(b.x)], 1u);
    return b;
}
__device__ __forceinline__ void xcd_barrier_complete(unsigned* bar, unsigned x, unsigned& nloc, unsigned& nx) {
    const unsigned G = gridDim.x * gridDim.y * gridDim.z;
    unsigned sum, cnt, mine, sp = 0u;
    for (;;) {
        sum = 0u; cnt = 0u; mine = 0u;
#pragma unroll
        for (unsigned j = 0; j < 16; ++j) { const unsigned c = xb_ld(&bar[XB_XCNT(j)]); sum += c; cnt += (c > 0u) ? 1u : 0u; mine = (j == x) ? c : mine; }
        if (sum == G) break;
        __builtin_amdgcn_s_sleep(1);
        if ((++sp & 255u) == 0u) { if (xb_ld(&bar[XB_TMO])) break; if (sp > XB_SPIN_CAP) { atomicAdd(&bar[XB_TMO], 1u); break; } }
    }
    nloc = mine > 0u ? mine : 1u; nx = cnt > 0u ? cnt : 1u;
}
__device__ __forceinline__ int lane_id_v() { int l_; asm volatile("v_mbcnt_lo_u32_b32 %0, -1, 0\n\tv_mbcnt_hi_u32_b32 %0, -1, %0" : "=v"(l_)); return l_; }
__device__ __forceinline__ void xcd_barrier(const XcdBarrier& b, int wave) {
    asm volatile("s_waitcnt vmcnt(0)" ::: "memory");
    __syncthreads();
    if (wave == 0 && lane_id_v() == 0) {
        unsigned* bar = b.bar;
        __builtin_amdgcn_s_waitcnt(0);
        unsigned nloc = b.st[0], nx = b.st[1];
        if (nloc == 0u) { xcd_barrier_complete(bar, b.x, nloc, nx); b.st[0] = nloc; b.st[1] = nx; }
        const unsigned old = xb_add(&bar[XB_XSUB(b.x)], 1u);
        const unsigned gen = old / nloc;
        if (old + 1u == (gen + 1u) * nloc) {
            __builtin_amdgcn_fence(__ATOMIC_RELEASE, "agent");
            asm volatile("s_waitcnt vmcnt(0)" ::: "memory");
            const unsigned og = xb_add(&bar[XB_TOP], 1u);
            const unsigned tg = og / nx;
            if (og + 1u == (tg + 1u) * nx) xb_add(&bar[XB_TOPGEN], 1u);
            else XB_SPIN(xb_ld(&bar[XB_TOPGEN]) == tg, bar);
            __builtin_amdgcn_fence(__ATOMIC_ACQUIRE, "agent");
            xb_add(&bar[XB_XGEN(b.x)], 1u);
            asm volatile("s_waitcnt vmcnt(0)" ::: "memory");
        } else {
            XB_SPIN(xb_ld(&bar[XB_XGEN(b.x)]) == gen, bar);
            __builtin_amdgcn_fence(__ATOMIC_ACQUIRE, "agent");
            asm volatile("s_waitcnt vmcnt(0)" ::: "memory");
        }
    }
    __syncthreads();
}

struct Frame {
    LAS unsigned char* lds;
    int tid, lane, wave;
    int vcu, G;
};

__device__ __forceinline__ float wave_sum(float v) {
#pragma unroll
    for (int o = 1; o < 64; o <<= 1) v += __shfl_xor(v, o);
    return v;
}

__device__ __forceinline__ void p0_tr_item(const float* src, size_t ld_src, bf16* dst, size_t ld_dst, int k0, int n0, LAS float* scr, int lane) {
#pragma unroll 8
    for (int i = 0; i < 32; ++i) { const int kk = 2 * i + (lane >> 5); scr[kk * 33 + (lane & 31)] = src[(size_t)(k0 + kk) * ld_src + n0 + (lane & 31)]; }
    LDS_WAIT(); asm volatile("" ::: "memory");
    const int c = lane & 7;
#pragma unroll
    for (int j = 0; j < 4; ++j) { const int n = (lane >> 3) + 8 * j; const LAS float* s = scr + (8 * c) * 33 + n;
        v4u o; o.x = pk2(s[0 * 33], s[1 * 33]); o.y = pk2(s[2 * 33], s[3 * 33]); o.z = pk2(s[4 * 33], s[5 * 33]); o.w = pk2(s[6 * 33], s[7 * 33]);
        *(GAS v4u*)(dst + (size_t)(n0 + n) * ld_dst + k0 + 8 * c) = o; }
    LDS_WAIT(); asm volatile("" ::: "memory");
}
__device__ __forceinline__ void p0_prologue(Frame& F) {
    KArgs ka = kargs(); unsigned char* const ws_p = ka->ws; float* const out_p = ka->out; const float* xp_ = ka->in[0]; const float* xs_ = ka->in[1]; const float* ck_ = ka->in[3]; const float* cv_ = ka->in[4]; const float* npre_ = ka->in[5]; const float* win_ = ka->in[6];
    const float* wpa_ = ka->in[10]; const float* wpb_ = ka->in[11]; const float* wo_ = ka->in[12];
    LAS float* scr = (LAS float*)(F.lds + F.wave * 16384);
    const int gw = F.vcu * NWAVES + F.wave, NGW = F.G * NWAVES;
    bf16* W1T = (bf16*)(ws_p + WS_W1T); bf16* W2T = (bf16*)(ws_p + WS_W2T); bf16* W3T = (bf16*)(ws_p + WS_W3T);
    bf16* KB = (bf16*)(ws_p + WS_KB); bf16* VB = (bf16*)(ws_p + WS_VB);
    constexpr int I1 = (DM / 64) * (DIN / 32), I2 = (1024 / 64) * (DM / 32), I3 = (DM / 64) * (DM / 32), I4 = DBATCH * HB * 16;
    constexpr int NITEMS = I1 + 2 * I2 + I3 + I4;
    for (int it = gw; it < NITEMS; it += NGW) {
        int r = it;
        if (r < I1) { const int nb = DIN / 32; p0_tr_item(win_, DIN, W1T, DM, 64 * (r / nb), 32 * (r % nb), scr, F.lane); continue; } r -= I1;
        if (r < I2) { const int nb = DM / 32; p0_tr_item(wpa_, DM, W2T, 2048, 64 * (r / nb), 32 * (r % nb), scr, F.lane); continue; } r -= I2;
        if (r < I2) { const int nb = DM / 32; p0_tr_item(wpb_, DM, W2T + 1024, 2048, 64 * (r / nb), 32 * (r % nb), scr, F.lane); continue; } r -= I2;
        if (r < I3) { const int nb = DM / 32; p0_tr_item(wo_, DM, W3T, DM, 64 * (r / nb), 32 * (r % nb), scr, F.lane); continue; } r -= I3;
        { const int sh = r >> 4, q = r & 15, sb = sh >> 4, h = sh & 15;
          p0_tr_item(cv_ + (size_t)sb * KVROWS * 1024 + h * 64, 1024, VB + KB_S + (size_t)sh * 64 * TS, TS, 64 * (q >> 1), 32 * (q & 1), scr, F.lane); }
    }
    { const int gt = gw * 64 + F.lane, NT = NGW * 64;
      for (int i = gt; i < DBATCH * KVROWS * 1024 / 8; i += NT) { const size_t e = (size_t)i * 8; const int sb = (int)(e >> 19), rem = (int)(e & 524287), t = rem >> 10, c = rem & 1023, h = c >> 6, d = c & 63;
          const f32x4 a = *(const GAS f32x4*)(ck_ + e), b = *(const GAS f32x4*)(ck_ + e + 4);
          v4u o; o.x = pk2(a.x, a.y); o.y = pk2(a.z, a.w); o.z = pk2(b.x, b.y); o.w = pk2(b.z, b.w);
          *(GAS v4u*)(KB + KB_S + (((size_t)(sb * 16 + h) * TS + t) * 64 + d)) = o; } }
    { bf16* XN = (bf16*)out_p; f32x4 g[8];
#pragma unroll
      for (int j = 0; j < 8; ++j) g[j] = ((const GAS f32x4*)npre_)[F.lane + 64 * j];
      for (int m = gw; m < M; m += NGW) { const float* xrow = m < MP ? xp_ + (size_t)m * DM : xs_ + (size_t)(m - MP) * DM;
          const GAS f32x4* xr = (const GAS f32x4*)xrow + F.lane; f32x4 v[8]; float s = 0.f;
#pragma unroll
          for (int j = 0; j < 8; ++j) { v[j] = xr[64 * j]; s += (v[j].x * v[j].x + v[j].y * v[j].y) + (v[j].z * v[j].z + v[j].w * v[j].w); }
          const float rstd = 1.0f / sqrtf(wave_sum(s) * (1.0f / DM) + EPS);
          GAS v2u* o8 = (GAS v2u*)(XN + (size_t)m * DM) + F.lane;
#pragma unroll
          for (int j = 0; j < 8; ++j) { v2u o; o.x = pk2(v[j].x * rstd * g[j].x, v[j].y * rstd * g[j].y); o.y = pk2(v[j].z * rstd * g[j].z, v[j].w * rstd * g[j].w); o8[64 * j] = o; } } }
}

constexpr int ATT_TBL_PITCH = 260, ATT_ST_OFF = 16 * ATT_TBL_PITCH * 4, ATT_ST_BYTES = 32 * 144;
template <bool SAMPLE_ONLY> __device__ __forceinline__ void attn_phase(Frame& F, const bool dummy = false) {
    typedef float f4 __attribute__((ext_vector_type(4)));
    LAS float* tbl = (LAS float*)F.lds; KArgs ka = kargs(); const float* rb_ = ka->in[9]; unsigned char* const ws_p = ka->ws;
    for (int i = F.tid; i < 16 * 257; i += NWAVES * 64) { const int h = i / 257, j = i % 257; tbl[h * ATT_TBL_PITCH + j] = rb_[i] * LOG2E; }
    __syncthreads();
    LAS unsigned char* st = F.lds + ATT_ST_OFF + F.wave * ATT_ST_BYTES;
    bf16* OAB = (bf16*)(ws_p + WS_OAB); const bf16* GB = (const bf16*)(ws_p + WS_GB);
    const bf16* KB = (const bf16*)(ws_p + WS_KB); const bf16* VB = (const bf16*)(ws_p + WS_VB);
    const int lane = F.lane, l15 = lane & 15, g = lane >> 4;
    const int gw = F.vcu * NWAVES + F.wave, NGW = F.G * NWAVES;
    constexpr int NWU = SAMPLE_ONLY ? DBATCH * HB * 2 : NCH * HB * 2;
    for (int wu = SAMPLE_ONLY ? (F.wave * F.G + F.vcu) : gw; wu < NWU; wu += NGW) {
        const int half = wu & 1, r = wu >> 1, gc = SAMPLE_ONLY ? 512 + (r & 15) : r % NCH, h = SAMPLE_ONLY ? (r >> 4) : r / NCH;
        const bf16* Kp; const bf16* Vp; int vpitch, kc0, kc1, cq;
        if (gc < 512) { const int b = gc >> 6, c = gc & 63; Kp = KB + (size_t)(b * 16 + h) * SEQ * 64; Vp = VB + (size_t)(b * 16 + h) * 64 * SEQ; vpitch = SEQ; cq = c; kc0 = c > 8 ? c - 8 : 0; kc1 = c; }
        else { const int sb = gc - 512; Kp = KB + KB_S + (size_t)(sb * 16 + h) * TS * 64; Vp = VB + KB_S + (size_t)(sb * 16 + h) * 64 * TS; vpitch = TS; cq = 8; kc0 = 0; kc1 = 8; }
        const size_t m0 = (size_t)gc * 64 + half * 32;
        bf16* Qg = OAB + m0 * 2048 + 1024 + h * 64;
        bf16x8 qf[2][2];
#pragma unroll
        for (int mb = 0; mb < 2; ++mb)
#pragma unroll
            for (int ks = 0; ks < 2; ++ks) qf[mb][ks] = *(const bf16x8*)(Qg + (size_t)(16 * mb + l15) * 2048 + 32 * ks + 8 * g);
        f4 o[2][4]; float mrun[2][4], lrun[2][4];
#pragma unroll
        for (int mb = 0; mb < 2; ++mb) {
#pragma unroll
            for (int nd = 0; nd < 4; ++nd) o[mb][nd] = (f4){0.f, 0.f, 0.f, 0.f};
#pragma unroll
            for (int j = 0; j < 4; ++j) { mrun[mb][j] = -1e30f; lrun[mb][j] = 0.f; } }
        const LAS float* tb = tbl + h * ATT_TBL_PITCH;
        bf16x8 kf[4][2];
#pragma unroll
        for (int nb = 0; nb < 4; ++nb)
#pragma unroll
            for (int ks = 0; ks < 2; ++ks) kf[nb][ks] = *(const bf16x8*)(Kp + (size_t)(kc0 * 64 + 16 * nb + l15) * 64 + 32 * ks + 8 * g);
        for (int kc = kc0; kc <= kc1; ++kc) {
            bf16x8 vf[4][2], kn[4][2];
#pragma unroll
            for (int nd = 0; nd < 4; ++nd)
#pragma unroll
                for (int ks = 0; ks < 2; ++ks) vf[nd][ks] = *(const bf16x8*)(Vp + (size_t)(16 * nd + l15) * vpitch + kc * 64 + 32 * ks + 8 * g);
            const int kcn = kc < kc1 ? kc + 1 : kc;
#pragma unroll
            for (int nb = 0; nb < 4; ++nb)
#pragma unroll
                for (int ks = 0; ks < 2; ++ks) kn[nb][ks] = *(const bf16x8*)(Kp + (size_t)(kcn * 64 + 16 * nb + l15) * 64 + 32 * ks + 8 * g);
            f4 s[2][4];
#pragma unroll
            for (int mb = 0; mb < 2; ++mb)
#pragma unroll
                for (int nb = 0; nb < 4; ++nb) { f4 a = (f4){0.f, 0.f, 0.f, 0.f};
                    a = __builtin_amdgcn_mfma_f32_16x16x32_bf16(qf[mb][0], kf[nb][0], a, 0, 0, 0);
                    a = __builtin_amdgcn_mfma_f32_16x16x32_bf16(qf[mb][1], kf[nb][1], a, 0, 0, 0); s[mb][nb] = a; }
            const int dlt = cq - kc;
            if (dlt >= 3) { const float cb = tb[256];
#pragma unroll
                for (int mb = 0; mb < 2; ++mb)
#pragma unroll
                    for (int nb = 0; nb < 4; ++nb) s[mb][nb] += cb;
            } else {
#pragma unroll
                for (int mb = 0; mb < 2; ++mb)
#pragma unroll
                    for (int nb = 0; nb < 4; ++nb)
#pragma unroll
                        for (int j = 0; j < 4; ++j) { int dist = 64 * dlt + (32 * half + 16 * mb + 4 * g + j) - (16 * nb + l15); dist = dist > 128 ? 128 : dist; s[mb][nb][j] += tb[128 + dist]; }
            }
#pragma unroll
            for (int mb = 0; mb < 2; ++mb)
#pragma unroll
                for (int j = 0; j < 4; ++j) {
                    float mx = fmaxf(fmaxf(s[mb][0][j], s[mb][1][j]), fmaxf(s[mb][2][j], s[mb][3][j]));
                    mx = fmaxf(mx, __shfl_xor(mx, 1)); mx = fmaxf(mx, __shfl_xor(mx, 2)); mx = fmaxf(mx, __shfl_xor(mx, 4)); mx = fmaxf(mx, __shfl_xor(mx, 8));
                    const float mn = fmaxf(mrun[mb][j], mx), al = __builtin_amdgcn_exp2f(mrun[mb][j] - mn); mrun[mb][j] = mn;
                    float ps = 0.f;
#pragma unroll
                    for (int nb = 0; nb < 4; ++nb) { const float p = __builtin_amdgcn_exp2f(s[mb][nb][j] - mn); s[mb][nb][j] = p; ps += p; }
                    lrun[mb][j] = lrun[mb][j] * al + ps;
#pragma unroll
                    for (int nd = 0; nd < 4; ++nd) o[mb][nd][j] *= al;
                }
#pragma unroll
            for (int mb = 0; mb < 2; ++mb)
#pragma unroll
                for (int nb = 0; nb < 4; ++nb)
#pragma unroll
                    for (int j = 0; j < 4; ++j) *(LAS bf16*)(st + (16 * mb + 4 * g + j) * 144 + (16 * nb + l15) * 2) = (bf16)f2bf(s[mb][nb][j]);
            bf16x8 pf[2][2];
#pragma unroll
            for (int mb = 0; mb < 2; ++mb)
#pragma unroll
                for (int ks = 0; ks < 2; ++ks) pf[mb][ks] = *(const LAS bf16x8*)(st + (16 * mb + l15) * 144 + (32 * ks + 8 * g) * 2);
#pragma unroll
            for (int mb = 0; mb < 2; ++mb)
#pragma unroll
                for (int nd = 0; nd < 4; ++nd) {
                    o[mb][nd] = __builtin_amdgcn_mfma_f32_16x16x32_bf16(pf[mb][0], vf[nd][0], o[mb][nd], 0, 0, 0);
                    o[mb][nd] = __builtin_amdgcn_mfma_f32_16x16x32_bf16(pf[mb][1], vf[nd][1], o[mb][nd], 0, 0, 0); }
#pragma unroll
            for (int nb = 0; nb < 4; ++nb)
#pragma unroll
                for (int ks = 0; ks < 2; ++ks) kf[nb][ks] = kn[nb][ks];
        }
#pragma unroll
        for (int mb = 0; mb < 2; ++mb)
#pragma unroll
            for (int j = 0; j < 4; ++j) { float l = lrun[mb][j]; l += __shfl_xor(l, 1); l += __shfl_xor(l, 2); l += __shfl_xor(l, 4); l += __shfl_xor(l, 8); const float rl = 1.0f / l;
#pragma unroll
                for (int nd = 0; nd < 4; ++nd) *(LAS bf16*)(st + (16 * mb + 4 * g + j) * 144 + (16 * nd + l15) * 2) = (bf16)f2bf(o[mb][nd][j] * rl); }
#pragma unroll
        for (int it = 0; it < 4; ++it) { const int row = it * 8 + (lane >> 3), oc = lane & 7;
            const v4u ov = *(const LAS v4u*)(st + row * 144 + oc * 16);
            const v4u gv = *(const GAS v4u*)(GB + (m0 + row) * 1024 + h * 64 + oc * 8);
            v4u w; w.x = pk2(bflo(ov.x) * bflo(gv.x), bfhi(ov.x) * bfhi(gv.x)); w.y = pk2(bflo(ov.y) * bflo(gv.y), bfhi(ov.y) * bfhi(gv.y));
            w.z = pk2(bflo(ov.z) * bflo(gv.z), bfhi(ov.z) * bfhi(gv.z)); w.w = pk2(bflo(ov.w) * bflo(gv.w), bfhi(ov.w) * bfhi(gv.w));
            if (dummy) *(GAS v4u*)((bf16*)(ws_p + 897 * MiB) + (m0 + row) * 1024 + h * 64 + oc * 8) = w; else *(GAS v4u*)(Qg + (size_t)row * 2048 + oc * 8) = w; }
    }
}

constexpr int A2_RING = ATT_ST_OFF, A2_KT = 64 * 144, A2_SLOT = 2 * A2_KT;
static_assert(A2_RING + 2 * A2_SLOT <= MISC_OFF, "attention LDS map");
__device__ __forceinline__ float xhalf_max(float x) { auto r = __builtin_amdgcn_permlane32_swap(__float_as_uint(x), __float_as_uint(x), false, false); return fmaxf(__uint_as_float(r[0]), __uint_as_float(r[1])); }
__device__ __forceinline__ float xhalf_sum(float x) { auto r = __builtin_amdgcn_permlane32_swap(__float_as_uint(x), __float_as_uint(x), false, false); return __uint_as_float(r[0]) + __uint_as_float(r[1]); }
__device__ __forceinline__ void attn2_phase(Frame& F) {
    KArgs ka = kargs(); unsigned char* const ws_p = ka->ws;
    LAS unsigned char* L = F.lds; const LAS float* tbl = (const LAS float*)L;
    bf16* OAB = (bf16*)(ws_p + WS_OAB); const bf16* GB = (const bf16*)(ws_p + WS_GB); const bf16* KB = (const bf16*)(ws_p + WS_KB); const bf16* VB = (const bf16*)(ws_p + WS_VB);
    const int tid = F.tid, lane = F.lane, w = F.wave, r32 = lane & 31, hh = lane >> 5;
    const int srow = tid >> 3, sc16 = tid & 7;
    const int pr = (r32 & ~12) | ((r32 & 4) << 1) | ((r32 & 8) >> 1);
    for (int uid = F.vcu; uid < NBATCH * HB * 16; uid += F.G) {
        const int j = uid >> 7, bh = uid & 127, b = bh >> 4, h = bh & 15;
        const int c = 4 * j + (w >> 1), half = w & 1, lo = c > 8 ? c - 8 : 0, hi = c;
        const int kt0 = j > 2 ? 4 * j - 8 : 0, kt1 = 4 * j + 3;
        const size_t m0 = (size_t)(b * 64 + c) * 64 + 32 * half;
        const bf16* Kg = KB + (size_t)bh * SEQ * 64 + srow * 64 + sc16 * 8;
        const bf16* Vg = VB + ((size_t)bh * 64 + srow) * SEQ + sc16 * 8;
        bf16x8 qf[4];
#pragma unroll
        for (int ks = 0; ks < 4; ++ks) qf[ks] = *(const bf16x8*)(OAB + (m0 + r32) * 2048 + 1024 + h * 64 + 16 * ks + 8 * hh);
        { const v4u k0 = *(const v4u*)(Kg + (size_t)kt0 * 4096), v0 = *(const v4u*)(Vg + kt0 * 64);
          *(LAS v4u*)(L + A2_RING + srow * 144 + sc16 * 16) = k0; *(LAS v4u*)(L + A2_RING + A2_KT + srow * 144 + sc16 * 16) = v0; }
        __syncthreads();
        f32x16 ot[2]; ot[0] = f32x16{}; ot[1] = f32x16{}; float mrun = -1e30f, lrun = 0.f;
        const LAS float* tb = tbl + h * ATT_TBL_PITCH; const int qi = 32 * half + r32;
        for (int kc = kt0; kc <= kt1; ++kc) {
            const int slot = (kc - kt0) & 1; const LAS unsigned char* Ks = L + A2_RING + slot * A2_SLOT; const LAS unsigned char* Vs = Ks + A2_KT;
            v4u kn = {}, vn = {};
            if (kc < kt1) { kn = *(const v4u*)(Kg + (size_t)(kc + 1) * 4096); vn = *(const v4u*)(Vg + (kc + 1) * 64); }
            if (kc >= lo && kc <= hi) {
                f32x16 st[2];
#pragma unroll
                for (int blk = 0; blk < 2; ++blk) { st[blk] = f32x16{};
#pragma unroll
                    for (int ks = 0; ks < 4; ++ks) { const bf16x8 a = *(const LAS bf16x8*)(Ks + (32 * blk + pr) * 144 + (16 * ks + 8 * hh) * 2); st[blk] = __builtin_amdgcn_mfma_f32_32x32x16_bf16(a, qf[ks], st[blk], 0, 0, 0); } }
                const int dlt = c - kc;
                if (dlt >= 3) { const float cb = tb[256];
#pragma unroll
                    for (int blk = 0; blk < 2; ++blk)
#pragma unroll
                        for (int e = 0; e < 16; ++e) st[blk][e] += cb;
                } else { const int base = 128 + 64 * dlt + qi - 8 * hh;
#pragma unroll
                    for (int blk = 0; blk < 2; ++blk)
#pragma unroll
                        for (int e = 0; e < 16; ++e) { int idx = base - (32 * blk + 16 * (e >> 3) + (e & 7)); idx = idx > 256 ? 256 : idx; st[blk][e] += tb[idx]; } }
                float mx = st[0][0];
#pragma unroll
                for (int e = 1; e < 16; ++e) mx = fmaxf(mx, st[0][e]);
#pragma unroll
                for (int e = 0; e < 16; ++e) mx = fmaxf(mx, st[1][e]);
                mx = xhalf_max(mx);
                const float mn = fmaxf(mrun, mx), al = __builtin_amdgcn_exp2f(mrun - mn); mrun = mn;
                float ps = 0.f;
#pragma unroll
                for (int blk = 0; blk < 2; ++blk)
#pragma unroll
                    for (int e = 0; e < 16; ++e) { const float p = __builtin_amdgcn_exp2f(st[blk][e] - mn); st[blk][e] = p; ps += p; }
                lrun = lrun * al + ps;
#pragma unroll
                for (int db = 0; db < 2; ++db)
#pragma unroll
                    for (int e = 0; e < 16; ++e) ot[db][e] *= al;
#pragma unroll
                for (int blk = 0; blk < 2; ++blk)
#pragma unroll
                    for (int sx = 0; sx < 2; ++sx) {
                        v4u pw; pw.x = pk2(st[blk][8 * sx], st[blk][8 * sx + 1]); pw.y = pk2(st[blk][8 * sx + 2], st[blk][8 * sx + 3]); pw.z = pk2(st[blk][8 * sx + 4], st[blk][8 * sx + 5]); pw.w = pk2(st[blk][8 * sx + 6], st[blk][8 * sx + 7]);
                        const bf16x8 pf = __builtin_bit_cast(bf16x8, pw);
#pragma unroll
                        for (int db = 0; db < 2; ++db) { const bf16x8 a = *(const LAS bf16x8*)(Vs + (32 * db + r32) * 144 + (32 * blk + 16 * sx + 8 * hh) * 2); ot[db] = __builtin_amdgcn_mfma_f32_32x32x16_bf16(a, pf, ot[db], 0, 0, 0); } }
            }
            if (kc < kt1) { LAS unsigned char* Kd = L + A2_RING + (slot ^ 1) * A2_SLOT; *(LAS v4u*)(Kd + srow * 144 + sc16 * 16) = kn; *(LAS v4u*)(Kd + A2_KT + srow * 144 + sc16 * 16) = vn; }
            __syncthreads();
        }
        const float inv = 1.0f / xhalf_sum(lrun);
#pragma unroll
        for (int db = 0; db < 2; ++db)
#pragma unroll
            for (int g = 0; g < 4; ++g) { const int d0 = 32 * db + 8 * g + 4 * hh;
                const v2u gv = *(const GAS v2u*)(GB + (m0 + r32) * 1024 + h * 64 + d0);
                v2u o; o.x = pk2(ot[db][4 * g] * inv * bflo(gv.x), ot[db][4 * g + 1] * inv * bfhi(gv.x)); o.y = pk2(ot[db][4 * g + 2] * inv * bflo(gv.y), ot[db][4 * g + 3] * inv * bfhi(gv.y));
                *(GAS v2u*)(OAB + (m0 + r32) * 2048 + 1024 + h * 64 + d0) = o; }
    }
}

constexpr float ATT_THR = 48.0f;
constexpr int A3_TBL_BYTES = 16 * 256 * 4, A3_RING = A3_TBL_BYTES;
static_assert(A3_RING + 2 * A2_SLOT <= MISC_OFF, "attention v3 LDS map");
__device__ __forceinline__ void attn3_phase(Frame& F) {
    KArgs ka = kargs(); unsigned char* const ws_p = ka->ws; const float* rb_ = ka->in[9];
    LAS unsigned char* L = F.lds; LAS float* trev = (LAS float*)L;
    for (int i = F.tid; i < 16 * 256; i += NWAVES * 64) { const int h = i >> 8, ri = i & 255; int idx = 319 - ri; idx = idx > 256 ? 256 : idx; trev[i] = rb_[h * 257 + idx] * LOG2E; }
    __syncthreads();
    bf16* OAB = (bf16*)(ws_p + WS_OAB); const bf16* GB = (const bf16*)(ws_p + WS_GB); const bf16* KB = (const bf16*)(ws_p + WS_KB); const bf16* VB = (const bf16*)(ws_p + WS_VB);
    const int tid = F.tid, lane = F.lane, w = F.wave, r32 = lane & 31, hh = lane >> 5;
    const int srow = tid >> 3, sc16 = tid & 7;
    const int pr = (r32 & ~12) | ((r32 & 4) << 1) | ((r32 & 8) >> 1);
    constexpr int NU = NBATCH * HB * 16 + DBATCH * HB;
    for (int uid = F.vcu; uid < NU; uid += F.G) {
        int h, c, lo, hi, kt0, kt1, vpitch; size_t m0; const bf16* Kg; const bf16* Vg; const int half = w & 1;
        if (uid < NBATCH * HB * 16) { const int j = uid >> 7, bh = uid & 127, b = bh >> 4; h = bh & 15;
            c = 4 * j + (w >> 1); lo = c > 8 ? c - 8 : 0; hi = c; kt0 = j > 2 ? 4 * j - 8 : 0; kt1 = 4 * j + 3; vpitch = SEQ;
            m0 = (size_t)(b * 64 + c) * 64 + 32 * half;
            Kg = KB + (size_t)bh * SEQ * 64 + srow * 64 + sc16 * 8; Vg = VB + ((size_t)bh * 64 + srow) * SEQ + sc16 * 8;
        } else { const int su = uid - NBATCH * HB * 16, sb = su & 15; h = su >> 4;
            c = 8; lo = (w >> 1) == 0 ? 0 : 1; hi = (w >> 1) == 0 ? 8 : 0; kt0 = 0; kt1 = 8; vpitch = TS;
            m0 = (size_t)(512 + sb) * 64 + 32 * half;
            Kg = KB + KB_S + (size_t)(sb * 16 + h) * TS * 64 + srow * 64 + sc16 * 8; Vg = VB + KB_S + ((size_t)(sb * 16 + h) * 64 + srow) * TS + sc16 * 8; }
        bf16x8 qf[4];
#pragma unroll
        for (int ks = 0; ks < 4; ++ks) qf[ks] = *(const bf16x8*)(OAB + (m0 + r32) * 2048 + 1024 + h * 64 + 16 * ks + 8 * hh);
        { const v4u k0 = *(const v4u*)(Kg + (size_t)kt0 * 4096), v0 = *(const v4u*)(Vg + kt0 * 64);
          *(LAS v4u*)(L + A3_RING + srow * 144 + sc16 * 16) = k0; *(LAS v4u*)(L + A3_RING + A2_KT + srow * 144 + sc16 * 16) = v0; }
        __syncthreads();
        f32x16 ot[2]; ot[0] = f32x16{}; ot[1] = f32x16{}; float mrun = 0.f, lrun = 0.f; bool first = true;
        const LAS float* tb = trev + h * 256; const int qi = 32 * half + r32; const float cb3 = tb[0];
        for (int kc = kt0; kc <= kt1; ++kc) {
            const int slot = (kc - kt0) & 1; const LAS unsigned char* Ks = L + A3_RING + slot * A2_SLOT; const LAS unsigned char* Vs = Ks + A2_KT;
            v4u kn = {}, vn = {};
            if (kc < kt1) { kn = *(const v4u*)(Kg + (size_t)(kc + 1) * 4096); vn = *(const v4u*)(Vg + (kc + 1) * 64); }
            if (kc >= lo && kc <= hi) {
                const int dlt = c - kc; const float ci = (dlt >= 3 ? cb3 : 0.f) - mrun;
                f32x16 st[2];
#pragma unroll
                for (int blk = 0; blk < 2; ++blk) {
#pragma unroll
                    for (int e = 0; e < 16; ++e) st[blk][e] = ci;
#pragma unroll
                    for (int ks = 0; ks < 4; ++ks) { const bf16x8 a = *(const LAS bf16x8*)(Ks + (32 * blk + pr) * 144 + (16 * ks + 8 * hh) * 2); st[blk] = __builtin_amdgcn_mfma_f32_32x32x16_bf16(a, qf[ks], st[blk], 0, 0, 0); } }
                if (dlt < 3) { const LAS float* tp = tb + (191 - 64 * dlt - qi + 8 * hh);
#pragma unroll
                    for (int blk = 0; blk < 2; ++blk)
#pragma unroll
                        for (int e = 0; e < 16; ++e) st[blk][e] += tp[32 * blk + 16 * (e >> 3) + (e & 7)]; }
                float mx = fmaxf(fmaxf(st[0][0], st[0][1]), st[0][2]);
#pragma unroll
                for (int e = 3; e < 15; e += 2) mx = fmaxf(fmaxf(mx, st[0][e]), st[0][e + 1]);
                mx = fmaxf(mx, st[0][15]);
#pragma unroll
                for (int e = 0; e < 16; e += 2) mx = fmaxf(fmaxf(mx, st[1][e]), st[1][e + 1]);
                mx = xhalf_max(mx);
                const float d = (first || mx > ATT_THR) ? mx : 0.f;
                if (__any(d != 0.f)) {
                    const float sc = __builtin_amdgcn_exp2f(-d); mrun += d; lrun *= sc;
#pragma unroll
                    for (int db = 0; db < 2; ++db)
#pragma unroll
                        for (int e = 0; e < 16; ++e) ot[db][e] *= sc;
#pragma unroll
                    for (int blk = 0; blk < 2; ++blk)
#pragma unroll
                        for (int e = 0; e < 16; ++e) st[blk][e] -= d; }
                first = false;
                float ps0 = 0.f, ps1 = 0.f;
#pragma unroll
                for (int blk = 0; blk < 2; ++blk)
#pragma unroll
                    for (int e = 0; e < 16; e += 2) { const float p0 = __builtin_amdgcn_exp2f(st[blk][e]), p1 = __builtin_amdgcn_exp2f(st[blk][e + 1]); st[blk][e] = p0; st[blk][e + 1] = p1; ps0 += p0; ps1 += p1; }
                lrun += ps0 + ps1;
#pragma unroll
                for (int blk = 0; blk < 2; ++blk)
#pragma unroll
                    for (int sx = 0; sx < 2; ++sx) {
                        v4u pw; pw.x = pk2(st[blk][8 * sx], st[blk][8 * sx + 1]); pw.y = pk2(st[blk][8 * sx + 2], st[blk][8 * sx + 3]); pw.z = pk2(st[blk][8 * sx + 4], st[blk][8 * sx + 5]); pw.w = pk2(st[blk][8 * sx + 6], st[blk][8 * sx + 7]);
                        const bf16x8 pf = __builtin_bit_cast(bf16x8, pw);
#pragma unroll
                        for (int db = 0; db < 2; ++db) { const bf16x8 a = *(const LAS bf16x8*)(Vs + (32 * db + r32) * 144 + (32 * blk + 16 * sx + 8 * hh) * 2); ot[db] = __builtin_amdgcn_mfma_f32_32x32x16_bf16(a, pf, ot[db], 0, 0, 0); } }
            }
            if (kc < kt1) { LAS unsigned char* Kd = L + A3_RING + (slot ^ 1) * A2_SLOT; *(LAS v4u*)(Kd + srow * 144 + sc16 * 16) = kn; *(LAS v4u*)(Kd + A2_KT + srow * 144 + sc16 * 16) = vn; }
            __syncthreads();
        }
        if (lo <= hi) {
            const float inv = 1.0f / xhalf_sum(lrun);
#pragma unroll
            for (int db = 0; db < 2; ++db)
#pragma unroll
                for (int g = 0; g < 4; ++g) { const int d0 = 32 * db + 8 * g + 4 * hh;
                    const v2u gv = *(const GAS v2u*)(GB + (m0 + r32) * 1024 + h * 64 + d0);
                    v2u o; o.x = pk2(ot[db][4 * g] * inv * bflo(gv.x), ot[db][4 * g + 1] * inv * bfhi(gv.x)); o.y = pk2(ot[db][4 * g + 2] * inv * bflo(gv.y), ot[db][4 * g + 3] * inv * bfhi(gv.y));
                    *(GAS v2u*)(OAB + (m0 + r32) * 2048 + 1024 + h * 64 + d0) = o; }
        }
    }
}

constexpr int HF_OFF = 0, HV_OFF = 32768, HQ_OFF = 66048, HO_OFF = 98816;
template <int MODE> __device__ __forceinline__ void hgrn_phase(Frame& F) {
    LAS float* Fs = (LAS float*)(F.lds + HF_OFF); LAS float* Vs = (LAS float*)(F.lds + HV_OFF); LAS float* Qs = (LAS float*)(F.lds + HQ_OFF); LAS float* O2 = (LAS float*)(F.lds + HO_OFF);
    const int tid = F.tid, lane = F.lane, w = F.wave; KArgs ka = kargs(); const float* gn_ = ka->in[8]; unsigned char* const ws_p = ka->ws; float* const out_p = ka->out;
    const bf16* LF = (const bf16*)(ws_p + WS_LF); const bf16* VA = (const bf16*)(ws_p + WS_VA); const bf16* GA = (const bf16*)(ws_p + WS_GA);
    bf16* OAB = (bf16*)(ws_p + WS_OAB); const bf16* ST = (const bf16*)(ws_p + WS_ST); float* DD = (float*)(ws_p + WS_DD); float* UT = out_p;
    const int dv = 32 * (w & 3) + (lane & 31), kq = (lane >> 5) + 2 * (w >> 2);
    for (int u = F.vcu; u < NUNIT; u += F.G) {
        const int gc = u >> 3, h = u & 7; const size_t m0 = (size_t)gc * 64; const size_t ub = (size_t)u * 8192;
#pragma unroll 4
        for (int i = 0; i < 16; ++i) { const int e = tid + 512 * i; Fs[e] = __expf(h2f(LF[ub + e]));
            if (MODE == 1) { const int t = e >> 7, k = e & 127; Qs[e] = bf2f(OAB[(m0 + t) * 2048 + h * 128 + k]); O2[e] = 0.f; } }
#pragma unroll 4
        for (int i = 0; i < 16; ++i) { const int e = tid + 512 * i; Vs[(e & 63) * 129 + (e >> 6)] = bf2f(VA[ub + e]); }
        if (MODE == 0 && tid < 128) { float s = 0.f;
#pragma unroll 8
            for (int t = 0; t < 64; ++t) s += h2f(LF[ub + t * 128 + tid]);
            DD[(size_t)u * 128 + tid] = __expf(s); }
        __syncthreads();
        float S[32];
        if (MODE == 1) { const v4u* sp = (const v4u*)(ST + (size_t)u * 16384 + dv * 128 + 32 * kq);
#pragma unroll
            for (int i = 0; i < 4; ++i) { const v4u x = sp[i]; S[8 * i + 0] = bflo(x.x); S[8 * i + 1] = bfhi(x.x); S[8 * i + 2] = bflo(x.y); S[8 * i + 3] = bfhi(x.y); S[8 * i + 4] = bflo(x.z); S[8 * i + 5] = bfhi(x.z); S[8 * i + 6] = bflo(x.w); S[8 * i + 7] = bfhi(x.w); }
        } else {
#pragma unroll
            for (int i = 0; i < 32; ++i) S[i] = 0.f; }
#pragma unroll 2
        for (int t = 0; t < 64; ++t) {
            const float v = Vs[t * 129 + dv]; float o = 0.f;
            const LAS f32x4* fp = (const LAS f32x4*)(Fs + t * 128 + 32 * kq); const LAS f32x4* qp = (const LAS f32x4*)(Qs + t * 128 + 32 * kq);
#pragma unroll
            for (int k4 = 0; k4 < 8; ++k4) { const f32x4 f = fp[k4];
#pragma unroll
                for (int e = 0; e < 4; ++e) S[4 * k4 + e] = f[e] * (S[4 * k4 + e] - v) + v;
                if (MODE == 1) { const f32x4 q = qp[k4];
#pragma unroll
                    for (int e = 0; e < 4; ++e) o += q[e] * S[4 * k4 + e]; } }
            if (MODE == 1) { o += __shfl_xor(o, 32); if (lane < 32) atomicAdd((float*)(O2 + t * 128 + dv), o); }
        }
        if (MODE == 0) { f32x4* up = (f32x4*)(UT + (size_t)u * 16384 + dv * 128 + 32 * kq);
#pragma unroll
            for (int i = 0; i < 8; ++i) up[i] = (f32x4){S[4 * i], S[4 * i + 1], S[4 * i + 2], S[4 * i + 3]};
        } else {
            __syncthreads();
            const int t = tid >> 3, sg = tid & 7; float ov[16]; float ss = 0.f;
#pragma unroll
            for (int e = 0; e < 16; ++e) { ov[e] = O2[t * 128 + 16 * sg + e]; ss += ov[e] * ov[e]; }
            ss += __shfl_xor(ss, 1); ss += __shfl_xor(ss, 2); ss += __shfl_xor(ss, 4);
            const float rstd = 1.0f / sqrtf(ss * (1.0f / 128.0f) + EPS);
            const v4u g0 = *(const v4u*)(GA + ub + t * 128 + 16 * sg), g1 = *(const v4u*)(GA + ub + t * 128 + 16 * sg + 8);
            const float* gn = gn_ + h * 128 + 16 * sg;
            float ga[16] = {bflo(g0.x), bfhi(g0.x), bflo(g0.y), bfhi(g0.y), bflo(g0.z), bfhi(g0.z), bflo(g0.w), bfhi(g0.w), bflo(g1.x), bfhi(g1.x), bflo(g1.y), bfhi(g1.y), bflo(g1.z), bfhi(g1.z), bflo(g1.w), bfhi(g1.w)};
            unsigned pw[8];
#pragma unroll
            for (int e = 0; e < 8; ++e) pw[e] = pk2(ov[2 * e] * rstd * gn[2 * e] * ga[2 * e], ov[2 * e + 1] * rstd * gn[2 * e + 1] * ga[2 * e + 1]);
            v4u* op = (v4u*)(OAB + (m0 + t) * 2048 + h * 128 + 16 * sg);
            op[0] = (v4u){pw[0], pw[1], pw[2], pw[3]}; op[1] = (v4u){pw[4], pw[5], pw[6], pw[7]};
        }
        __syncthreads();
    }
}
constexpr int HP = 136, HP64 = 72;
constexpr int L_TAU = 0, L_QT = 4096, L_QG = L_QT + 64 * HP * 2, L_KH = L_QG + 64 * HP * 2, L_VT = L_KH + 160 * HP * 2, L_ST = L_VT + 128 * HP64 * 2, L_A = L_ST + 128 * HP * 2, L_HEND = L_A + 64 * HP64 * 2;
constexpr int L_O2 = L_KH;
static_assert(L_HEND <= MISC_OFF && 64 * 128 * 4 <= 160 * HP * 2, "HGRN LDS map");
template <int MODE> __device__ __forceinline__ void hgrn_mfma_phase(Frame& F) {
    KArgs ka = kargs(); const float* gn_ = ka->in[8]; unsigned char* const ws_p = ka->ws; float* const out_p = ka->out;
    const bf16* LF = (const bf16*)(ws_p + WS_LF); const bf16* VA = (const bf16*)(ws_p + WS_VA); const bf16* GA = (const bf16*)(ws_p + WS_GA);
    bf16* OAB = (bf16*)(ws_p + WS_OAB); const bf16* ST = (const bf16*)(ws_p + WS_ST); float* DD = (float*)(ws_p + WS_DD); float* UT = out_p;
    LAS unsigned char* L = F.lds;
    const int tid = F.tid, lane = F.lane, w = F.wave, kp = lane, tg = w;
    for (int u = F.vcu; u < NUNIT; u += F.G) {
        const int gc = u >> 3, h = u & 7; const size_t m0 = (size_t)gc * 64; const size_t ub = (size_t)u * 8192;
        unsigned gw[8], qw[8];
#pragma unroll
        for (int j = 0; j < 8; ++j) gw[j] = *(const unsigned*)(LF + ub + (8 * tg + j) * 128 + 2 * kp);
        if (MODE == 1) {
#pragma unroll
            for (int j = 0; j < 8; ++j) qw[j] = *(const unsigned*)(OAB + (m0 + 8 * tg + j) * 2048 + h * 128 + 2 * kp); }
        { const v4u* vp = (const v4u*)(VA + ub + tid * 16); const v4u a = vp[0], b = vp[1];
          LAS v4u* d = (LAS v4u*)(L + L_VT + ((tid >> 2) * HP64 + (tid & 3) * 16) * 2); d[0] = a; d[1] = b; }
        if (MODE == 1) { const v4u* sp = (const v4u*)(ST + (size_t)u * 16384 + tid * 32); const v4u a = sp[0], b = sp[1], c = sp[2], e = sp[3];
          LAS v4u* d = (LAS v4u*)(L + L_ST + ((tid >> 2) * HP + (tid & 3) * 32) * 2); d[0] = a; d[1] = b; d[2] = c; d[3] = e; }
        float g0[8], g1[8], c0[8], c1[8]; float a0 = 0.f, a1 = 0.f;
#pragma unroll
        for (int j = 0; j < 8; ++j) { g0[j] = h2f((unsigned short)(gw[j] & 0xffffu)); g1[j] = h2f((unsigned short)(gw[j] >> 16)); a0 += g0[j]; a1 += g1[j]; c0[j] = a0; c1[j] = a1; }
        *(LAS f32x2_g*)(L + L_TAU + (tg * 128 + 2 * kp) * 4) = (f32x2_g){a0, a1};
        __syncthreads();
        float P0[9], P1[9]; P0[0] = 0.f; P1[0] = 0.f;
#pragma unroll
        for (int gq = 0; gq < 8; ++gq) { const f32x2_g t2 = *(const LAS f32x2_g*)(L + L_TAU + (gq * 128 + 2 * kp) * 4); P0[gq + 1] = P0[gq] + t2.x; P1[gq + 1] = P1[gq] + t2.y; }
        float pb0 = 0.f, pb1 = 0.f;
#pragma unroll
        for (int gq = 0; gq < 8; ++gq) if (gq == tg) { pb0 = P0[gq]; pb1 = P1[gq]; }
        if (MODE == 0) {
            const float bl0 = P0[8], bl1 = P1[8]; unsigned k0w[4], k1w[4];
#pragma unroll
            for (int j = 0; j < 8; j += 2) {
                const float x00 = (1.0f - __expf(g0[j])) * __expf(bl0 - (pb0 + c0[j])), x01 = (1.0f - __expf(g0[j + 1])) * __expf(bl0 - (pb0 + c0[j + 1]));
                const float x10 = (1.0f - __expf(g1[j])) * __expf(bl1 - (pb1 + c1[j])), x11 = (1.0f - __expf(g1[j + 1])) * __expf(bl1 - (pb1 + c1[j + 1]));
                k0w[j >> 1] = pk2(x00, x01); k1w[j >> 1] = pk2(x10, x11); }
            *(LAS v4u*)(L + L_KH + ((2 * kp) * HP64 + 8 * tg) * 2) = (v4u){k0w[0], k0w[1], k0w[2], k0w[3]};
            *(LAS v4u*)(L + L_KH + ((2 * kp + 1) * HP64 + 8 * tg) * 2) = (v4u){k1w[0], k1w[1], k1w[2], k1w[3]};
            if (tg == 0) *(f32x2_g*)(DD + (size_t)u * 128 + 2 * kp) = (f32x2_g){__expf(bl0), __expf(bl1)};
        } else {
            const int si = tg >> 1; float be0[4], be1[4];
#pragma unroll
            for (int ii = 0; ii < 4; ++ii) { be0[ii] = P0[2 * ii]; be1[ii] = P1[2 * ii]; }
            float bi0 = 0.f, bi1 = 0.f;
#pragma unroll
            for (int ii = 0; ii < 4; ++ii) if (ii == si) { bi0 = be0[ii]; bi1 = be1[ii]; }
#pragma unroll
            for (int j = 0; j < 8; ++j) { const int t = 8 * tg + j;
                const float b0 = pb0 + c0[j], b1 = pb1 + c1[j], q0 = bflo(qw[j]), q1 = bfhi(qw[j]);
                *(LAS unsigned*)(L + L_QT + (t * HP + 2 * kp) * 2) = pk2(q0 * __expf(b0 - bi0), q1 * __expf(b1 - bi1));
                *(LAS unsigned*)(L + L_QG + (t * HP + 2 * kp) * 2) = pk2(q0 * __expf(b0), q1 * __expf(b1));
                const float kv0 = 1.0f - __expf(g0[j]), kv1 = 1.0f - __expf(g1[j]);
#pragma unroll
                for (int ii = 0; ii < 4; ++ii) if (ii >= si) {
                    *(LAS unsigned*)(L + L_KH + ((8 * ii * (ii + 1) + t) * HP + 2 * kp) * 2) = pk2(kv0 * __expf(be0[ii] - b0), kv1 * __expf(be1[ii] - b1)); } }
        }
        __syncthreads();
        const int r32 = lane & 31, hh = lane >> 5, l15 = lane & 15, g4 = lane >> 4;
        if (MODE == 0) {
#pragma unroll
            for (int ti = 0; ti < 2; ++ti) { const int T2 = 2 * w + ti, kb = T2 >> 2, db = T2 & 3; f32x16 acc = {};
#pragma unroll
                for (int ks = 0; ks < 4; ++ks) { const bf16x8 a = *(const LAS bf16x8*)(L + L_KH + ((32 * kb + r32) * HP64 + 16 * ks + 8 * hh) * 2), b = *(const LAS bf16x8*)(L + L_VT + ((32 * db + r32) * HP64 + 16 * ks + 8 * hh) * 2);
                    acc = __builtin_amdgcn_mfma_f32_32x32x16_bf16(a, b, acc, 0, 0, 0); }
                float* up = UT + (size_t)u * 16384 + (32 * db + r32) * 128 + 32 * kb + 4 * hh;
#pragma unroll
                for (int q4 = 0; q4 < 4; ++q4) *(f32x4*)(up + 8 * q4) = (f32x4){acc[4 * q4], acc[4 * q4 + 1], acc[4 * q4 + 2], acc[4 * q4 + 3]}; }
        } else {
#pragma unroll
            for (int bi = 0; bi < 2; ++bi) { const int blk = w + 8 * bi; if (blk < 10) {
                const int i = blk < 1 ? 0 : blk < 3 ? 1 : blk < 6 ? 2 : 3, j = blk - (i * (i + 1)) / 2; f32x4 acc = {};
#pragma unroll
                for (int ks = 0; ks < 4; ++ks) { const bf16x8 a = *(const LAS bf16x8*)(L + L_QT + ((16 * i + l15) * HP + 32 * ks + 8 * g4) * 2), b = *(const LAS bf16x8*)(L + L_KH + ((8 * i * (i + 1) + 16 * j + l15) * HP + 32 * ks + 8 * g4) * 2);
                    acc = __builtin_amdgcn_mfma_f32_16x16x32_bf16(a, b, acc, 0, 0, 0); }
#pragma unroll
                for (int e = 0; e < 4; ++e) { const int t = 16 * i + 4 * g4 + e, s = 16 * j + l15; *(LAS bf16*)(L + L_A + (t * HP64 + s) * 2) = (bf16)f2bf((i == j && s > t) ? 0.f : acc[e]); } } }
            if (w >= 2) { const int z = w - 2, i = z < 3 ? 0 : z < 5 ? 1 : 2, j = z < 3 ? z + 1 : z < 5 ? z - 1 : 3;
#pragma unroll
                for (int e = 0; e < 4; ++e) *(LAS bf16*)(L + L_A + ((16 * i + 4 * g4 + e) * HP64 + 16 * j + l15) * 2) = (bf16)0; }
            __syncthreads();
            { const int tb = w >> 2, db = w & 3; f32x16 acc = {};
#pragma unroll
              for (int ks = 0; ks < 8; ++ks) { const bf16x8 a = *(const LAS bf16x8*)(L + L_QG + ((32 * tb + r32) * HP + 16 * ks + 8 * hh) * 2), b = *(const LAS bf16x8*)(L + L_ST + ((32 * db + r32) * HP + 16 * ks + 8 * hh) * 2);
                  acc = __builtin_amdgcn_mfma_f32_32x32x16_bf16(a, b, acc, 0, 0, 0); }
#pragma unroll
              for (int ks = 0; ks < 4; ++ks) { const bf16x8 a = *(const LAS bf16x8*)(L + L_A + ((32 * tb + r32) * HP64 + 16 * ks + 8 * hh) * 2), b = *(const LAS bf16x8*)(L + L_VT + ((32 * db + r32) * HP64 + 16 * ks + 8 * hh) * 2);
                  acc = __builtin_amdgcn_mfma_f32_32x32x16_bf16(a, b, acc, 0, 0, 0); }
#pragma unroll
              for (int e = 0; e < 16; ++e) *(LAS float*)(L + L_O2 + ((32 * tb + (e & 3) + 8 * (e >> 2) + 4 * hh) * 128 + 32 * db + r32) * 4) = acc[e]; }
            __syncthreads();
            const LAS float* O2 = (const LAS float*)(L + L_O2);
            const int t = tid >> 3, sg = tid & 7; float ov[16]; float ss = 0.f;
#pragma unroll
            for (int e = 0; e < 16; ++e) { ov[e] = O2[t * 128 + 16 * sg + e]; ss += ov[e] * ov[e]; }
            ss += __shfl_xor(ss, 1); ss += __shfl_xor(ss, 2); ss += __shfl_xor(ss, 4);
            const float rstd = 1.0f / sqrtf(ss * (1.0f / 128.0f) + EPS);
            const v4u ga0 = *(const v4u*)(GA + ub + t * 128 + 16 * sg), ga1 = *(const v4u*)(GA + ub + t * 128 + 16 * sg + 8);
            const float* gn = gn_ + h * 128 + 16 * sg;
            float ga[16] = {bflo(ga0.x), bfhi(ga0.x), bflo(ga0.y), bfhi(ga0.y), bflo(ga0.z), bfhi(ga0.z), bflo(ga0.w), bfhi(ga0.w), bflo(ga1.x), bfhi(ga1.x), bflo(ga1.y), bfhi(ga1.y), bflo(ga1.z), bfhi(ga1.z), bflo(ga1.w), bfhi(ga1.w)};
            unsigned pw[8];
#pragma unroll
            for (int e = 0; e < 8; ++e) pw[e] = pk2(ov[2 * e] * rstd * gn[2 * e] * ga[2 * e], ov[2 * e + 1] * rstd * gn[2 * e + 1] * ga[2 * e + 1]);
            v4u* op = (v4u*)(OAB + (m0 + t) * 2048 + h * 128 + 16 * sg);
            op[0] = (v4u){pw[0], pw[1], pw[2], pw[3]}; op[1] = (v4u){pw[4], pw[5], pw[6], pw[7]};
        }
        __syncthreads();
    }
}
__device__ __forceinline__ void scan_phase(Frame& F) {
    KArgs ka = kargs(); const float* state_ = ka->in[2]; unsigned char* const ws_p = ka->ws; float* const out_p = ka->out;
    const int gt = F.vcu * 512 + F.tid, NT = F.G * 512;
    const float* UT = out_p; const float* DD = (const float*)(ws_p + WS_DD); bf16* ST = (bf16*)(ws_p + WS_ST);
    for (int item = gt; item < 64 * 128 * 16; item += NT) {
        const int ko = item & 15, dv = (item >> 4) & 127, sh = item >> 11, b = sh >> 3, h = sh & 7;
        float S[8];
#pragma unroll
        for (int e = 0; e < 8; ++e) S[e] = 0.f;
#pragma unroll 4
        for (int c = 0; c < 64; ++c) { const size_t u = (size_t)((b * 64 + c) * 8 + h);
            const f32x4 u0 = *(const f32x4*)(UT + u * 16384 + dv * 128 + 8 * ko), u1 = *(const f32x4*)(UT + u * 16384 + dv * 128 + 8 * ko + 4);
            const f32x4 d0 = *(const f32x4*)(DD + u * 128 + 8 * ko), d1 = *(const f32x4*)(DD + u * 128 + 8 * ko + 4);
            *(v4u*)(ST + u * 16384 + dv * 128 + 8 * ko) = (v4u){pk2(S[0], S[1]), pk2(S[2], S[3]), pk2(S[4], S[5]), pk2(S[6], S[7])};
#pragma unroll
            for (int e = 0; e < 4; ++e) { S[e] = d0[e] * S[e] + u0[e]; S[4 + e] = d1[e] * S[4 + e] + u1[e]; } }
#pragma unroll
        for (int e = 0; e < 8; ++e) out_p[O_SP + ((size_t)(sh * 128 + 8 * ko + e) * 128 + dv)] = S[e];
    }
    for (int item = gt; item < 128 * 128 * 16; item += NT) {
        const int ko = item & 15, dv = (item >> 4) & 127, ssh = item >> 11, sb = ssh >> 3, h = ssh & 7; const size_t u = (size_t)((512 + sb) * 8 + h);
        float S[8];
#pragma unroll
        for (int e = 0; e < 8; ++e) S[e] = state_[((size_t)(ssh * 128 + 8 * ko + e) * 128 + dv)];
        const f32x4 u0 = *(const f32x4*)(UT + u * 16384 + dv * 128 + 8 * ko), u1 = *(const f32x4*)(UT + u * 16384 + dv * 128 + 8 * ko + 4);
        const f32x4 d0 = *(const f32x4*)(DD + u * 128 + 8 * ko), d1 = *(const f32x4*)(DD + u * 128 + 8 * ko + 4);
        *(v4u*)(ST + u * 16384 + dv * 128 + 8 * ko) = (v4u){pk2(S[0], S[1]), pk2(S[2], S[3]), pk2(S[4], S[5]), pk2(S[6], S[7])};
#pragma unroll
        for (int e = 0; e < 4; ++e) { S[e] = d0[e] * S[e] + u0[e]; S[4 + e] = d1[e] * S[4 + e] + u1[e]; }
#pragma unroll
        for (int e = 0; e < 8; ++e) out_p[O_SS + ((size_t)(ssh * 128 + 8 * ko + e) * 128 + dv)] = S[e];
    }
}
__device__ __forceinline__ void final_phase(Frame& F) {
    KArgs ka = kargs(); unsigned char* const ws_p = ka->ws; float* const out_p = ka->out;
    const bf16* UO = (const bf16*)(ws_p + WS_UO); const float* SQ = (const float*)(ws_p + WS_SQ);
    const int gw = F.vcu * NWAVES + F.wave, NGW = F.G * NWAVES, lane = F.lane; const float* xp_ = ka->in[0]; const float* xs_ = ka->in[1]; const float* npost_ = ka->in[13];
    for (int m = gw; m < M; m += NGW) {
        const float sq = wave_sum(lane < 32 ? SQ[(size_t)m * 32 + lane] : 0.f);
        const float rstd = 1.0f / sqrtf(sq * (1.0f / DM) + EPS);
        const float* xrow = m < MP ? xp_ + (size_t)m * DM : xs_ + (size_t)(m - MP) * DM;
        float* yrow = out_p + (size_t)m * DM;
#pragma unroll
        for (int j = 0; j < 4; ++j) { const int c = 8 * (lane + 64 * j);
            const v4u uv = *(const GAS v4u*)(UO + (size_t)m * DM + c);
            const f32x4 x0 = *(const GAS f32x4*)(xrow + c), x1 = *(const GAS f32x4*)(xrow + c + 4), g0 = *(const GAS f32x4*)(npost_ + c), g1 = *(const GAS f32x4*)(npost_ + c + 4);
            f32x4 y0, y1;
            y0[0] = x0[0] + bflo(uv.x) * rstd * g0[0]; y0[1] = x0[1] + bfhi(uv.x) * rstd * g0[1]; y0[2] = x0[2] + bflo(uv.y) * rstd * g0[2]; y0[3] = x0[3] + bfhi(uv.y) * rstd * g0[3];
            y1[0] = x1[0] + bflo(uv.z) * rstd * g1[0]; y1[1] = x1[1] + bfhi(uv.z) * rstd * g1[1]; y1[2] = x1[2] + bflo(uv.w) * rstd * g1[2]; y1[3] = x1[3] + bfhi(uv.w) * rstd * g1[3];
            *(GAS f32x4*)(yrow + c) = y0; *(GAS f32x4*)(yrow + c + 4) = y1; }
    }
}

constexpr int N_PHASES = 9;
__global__ void __launch_bounds__(NWAVES * 64, 2) mk_fwd(Args args) {
    extern __shared__ __attribute__((aligned(16))) unsigned char lds[];
    Frame F;
    F.lds = (LAS unsigned char*)lds;
    F.tid = threadIdx.x; F.lane = F.tid & 63; F.wave = __builtin_amdgcn_readfirstlane(F.tid >> 6);
    F.G = gridDim.x; { const int bx = blockIdx.x; F.vcu = (F.G % 8 == 0) ? (bx % 8) * (F.G / 8) + bx / 8 : bx; }
    volatile LAS unsigned* MISC = (volatile LAS unsigned*)(F.lds + MISC_OFF);
    if (F.tid < 64) MISC[F.tid] = 0u;
    __syncthreads();
    gu32* ctl = (gu32*)(args.ws + WS_CTL);
    XcdBarrier bar; bar.bar = (unsigned*)(ctl + CW_BAR) + args.li * XCD_BAR_WORDS; bar.x = 0; bar.st = nullptr;
    const int lo = args.ph_lo, hi = args.ph_hi;
    if (hi - lo > 1) bar = xcd_barrier_post((unsigned*)(ctl + CW_BAR) + args.li * XCD_BAR_WORDS, MISC + 8);
#define IN(k) (lo <= (k) && (k) < hi)
#define SEAM(k) do { if (IN(k) && IN((k) + 1)) xcd_barrier(bar, F.wave); F.lane = lane_id_v(); F.tid = F.wave * 64 + F.lane; } while (0)
    using namespace pg8;
#if REPEAT_PHASE == 0
    if (IN(0) && ((PH_MASK >> 0) & 1)) { p0_prologue(F); }
#endif
    if (IN(0) && ((PH_MASK >> 0) & 1)) { p0_prologue(F); } SEAM(0);
#if REPEAT_PHASE == 1
    if (IN(1) && ((PH_MASK >> 1) & 1)) {
        Gemm g{(const bf16_t*)kargs()->out, (const bf16_t*)(kargs()->ws + WS_W1T), M, DIN, DM}; Order1 S; S.init(M, DIN, F.G, (int)blockIdx.x);
        Epi1 E{1};
        gemm_phase<Epi1, Order1, true, true>(F.lds, g, S, E, F.wave);
    }
#endif
    if (IN(1) && ((PH_MASK >> 1) & 1)) {
        Gemm g{(const bf16_t*)kargs()->out, (const bf16_t*)(kargs()->ws + WS_W1T), M, DIN, DM}; Order1 S; S.init(M, DIN, F.G, (int)blockIdx.x);
        Epi1 E{0};
        gemm_phase<Epi1, Order1, true, true>(F.lds, g, S, E, F.wave);
    } SEAM(1);
#if REPEAT_PHASE == 2
    if (IN(2) && ((PH_MASK >> 2) & 1)) { attn_phase<false>(F, true); }
#endif
    if (IN(2) && ((PH_MASK >> 2) & 1)) { attn3_phase(F); } SEAM(2);
#if REPEAT_PHASE == 3
    if (IN(3) && ((PH_MASK >> 3) & 1)) { hgrn_mfma_phase<0>(F); }
#endif
    if (IN(3) && ((PH_MASK >> 3) & 1)) { hgrn_mfma_phase<0>(F); } SEAM(3);
#if REPEAT_PHASE == 4
    if (IN(4) && ((PH_MASK >> 4) & 1)) { scan_phase(F); }
#endif
    if (IN(4) && ((PH_MASK >> 4) & 1)) { scan_phase(F); } SEAM(4);
#if REPEAT_PHASE == 5
    if (IN(5) && ((PH_MASK >> 5) & 1)) { hgrn_mfma_phase<1>(F); }
#endif
    if (IN(5) && ((PH_MASK >> 5) & 1)) { hgrn_mfma_phase<1>(F); } SEAM(5);
#if REPEAT_PHASE == 6
    if (IN(6) && ((PH_MASK >> 6) & 1)) {
        Gemm g{(const bf16_t*)(kargs()->ws + WS_OAB), (const bf16_t*)(kargs()->ws + WS_W2T), M, DM, DM}; StaticOrder S; S.init(M, DM, F.G, (int)blockIdx.x);
        Epi2 E{};
        gemm_phase<Epi2, StaticOrder, true, true>(F.lds, g, S, E, F.wave);
    }
#endif
    if (IN(6) && ((PH_MASK >> 6) & 1)) {
        Gemm g{(const bf16_t*)(kargs()->ws + WS_OAB), (const bf16_t*)(kargs()->ws + WS_W2T), M, DM, DM}; StaticOrder S; S.init(M, DM, F.G, (int)blockIdx.x);
        Epi2 E{};
        gemm_phase<Epi2, StaticOrder, true, true>(F.lds, g, S, E, F.wave);
    } SEAM(6);
#if REPEAT_PHASE == 7
    if (IN(7) && ((PH_MASK >> 7) & 1)) {
        Gemm g{(const bf16_t*)(kargs()->ws + WS_MG), (const bf16_t*)(kargs()->ws + WS_W3T), M, DM, DM}; StaticOrder S; S.init(M, DM, F.G, (int)blockIdx.x);
        Epi3 E{};
        gemm_phase<Epi3, StaticOrder, true, true>(F.lds, g, S, E, F.wave);
    }
#endif
    if (IN(7) && ((PH_MASK >> 7) & 1)) {
        Gemm g{(const bf16_t*)(kargs()->ws + WS_MG), (const bf16_t*)(kargs()->ws + WS_W3T), M, DM, DM}; StaticOrder S; S.init(M, DM, F.G, (int)blockIdx.x);
        Epi3 E{};
        gemm_phase<Epi3, StaticOrder, true, true>(F.lds, g, S, E, F.wave);
    } SEAM(7);
#if REPEAT_PHASE == 8
    if (IN(8) && ((PH_MASK >> 8) & 1)) { final_phase(F); }
#endif
    if (IN(8) && ((PH_MASK >> 8) & 1)) { final_phase(F); }
#undef IN
#undef SEAM
}

extern "C" void kernel_launch(void* const* d_in, const int* in_sizes, int n_in, void* d_out, int out_size, void* d_ws, size_t ws_size, hipStream_t stream) {
    static int grid = 0;
    if (grid == 0) {
        if (n_in != 14 || out_size != (int)O_END || ws_size < WS_END) { fprintf(stderr, "kernel_launch: unexpected shapes: n_in %d out %d ws %zu\n", n_in, out_size, ws_size); grid = -1; return; }
        int dev = 0, cus = 0, per_cu = 0;
        if (hipGetDevice(&dev) != hipSuccess || hipDeviceGetAttribute(&cus, hipDeviceAttributeMultiprocessorCount, dev) != hipSuccess) { grid = -1; return; }
        if (hipFuncSetAttribute((const void*)mk_fwd, hipFuncAttributeMaxDynamicSharedMemorySize, LDS_BYTES) != hipSuccess) { fprintf(stderr, "kernel_launch: hipFuncSetAttribute failed\n"); grid = -1; return; }
        if (hipOccupancyMaxActiveBlocksPerMultiprocessor(&per_cu, (const void*)mk_fwd, NWAVES * 64, LDS_BYTES) != hipSuccess || per_cu < 1)
            fprintf(stderr, "kernel_launch: note: occupancy query reports %d workgroups per CU\n", per_cu);
        (void)hipGetLastError();
        grid = cus;
    }
    if (grid < 0) return;
    if (hipMemsetAsync((char*)d_ws + WS_CTL, 0, CTL_ZERO_BYTES, stream) != hipSuccess) return;
    Args a{};
    for (int i = 0; i < 14; ++i) a.in[i] = (const float*)d_in[i];
    a.out = (float*)d_out; a.ws = (unsigned char*)d_ws;
    constexpr int NL = MK_N_LAUNCHES;
#ifndef PROBE_LAST
#define PROBE_LAST 8
#endif
    for (int li = 0; li < NL && li <= PROBE_LAST; ++li) {
        a.ph_lo = (NL == N_PHASES) ? li : (li * N_PHASES) / NL; a.ph_hi = (NL == N_PHASES) ? li + 1 : ((li + 1) * N_PHASES) / NL; a.li = li;
        hipLaunchKernelGGL(mk_fwd, dim3(grid), dim3(NWAVES * 64), LDS_BYTES, stream, a);
    }
#ifdef PROBE_COPY
    hipMemcpyAsync(d_out, (char*)d_ws + PROBE_COPY, (size_t)132 * MiB, hipMemcpyDeviceToDevice, stream);
#endif
}
```
